# Optimizing an MI355X kernel written in HIP

```python
import math
import jax, jax.numpy as jnp
from jax import lax
import numpy as np

D_MODEL = 1024
BATCH = 8
SEQ = 4096
DEPTH = 1

MLA_HEADS = 8
MLA_NOPE_DIM = 64
MLA_ROPE_DIM = 32
MLA_V_DIM = 64
MLA_Q_RANK = 256
MLA_KV_RANK = 128
FOX_HEADS = 8
FOX_HEAD_DIM = 64
FOX_WIDTH = FOX_HEADS * FOX_HEAD_DIM
MIX_WIDTH = MLA_HEADS * MLA_V_DIM + FOX_WIDTH
IN_SPLITS = [MLA_Q_RANK, MLA_KV_RANK, MLA_ROPE_DIM, FOX_WIDTH, FOX_WIDTH, FOX_WIDTH, FOX_HEADS]
IN_WIDTH = sum(IN_SPLITS)
ROPE_THETA = 10000.0
Q_BLOCK = 128
N_EXPERTS = 32
TOP_K = 4
D_FF_EXPERT = D_MODEL
SWIGLU_ALPHA = 1.702
SWIGLU_LIMIT = 7.0
EXPERT_BLOCK = 512
RMS_EPS = 1e-6
NEG_INF = -1e30

kernel_name = 'hybrid_mla_fox_moe_adaln_layer'


def rms_norm(x, g):
    xf = x.astype(jnp.float32)
    y = xf * lax.rsqrt(jnp.mean(xf * xf, axis=-1, keepdims=True) + RMS_EPS)
    return (y * g.astype(jnp.float32)).astype(x.dtype)


def rope_tables(positions):
    inv_freq = ROPE_THETA ** (-jnp.arange(0, MLA_ROPE_DIM, 2, dtype=jnp.float32) / MLA_ROPE_DIM)
    ang = positions.astype(jnp.float32)[..., None] * inv_freq
    return jnp.cos(ang), jnp.sin(ang)


def apply_rope(x, cos, sin):
    half = x.shape[-1] // 2
    x1, x2 = x[..., :half], x[..., half:]
    cos = cos.astype(x.dtype)
    sin = sin.astype(x.dtype)
    return jnp.concatenate([x1 * cos - x2 * sin, x1 * sin + x2 * cos], axis=-1)


def causal_block_attention(q, k, v, scale, log_forget_cum=None):
    S = q.shape[2]
    outs = []
    for i in range(S // Q_BLOCK):
        q0, q1 = i * Q_BLOCK, (i + 1) * Q_BLOCK
        s = jnp.einsum('bhqd,bhkd->bhqk', q[:, :, q0:q1], k[:, :, :q1]).astype(jnp.float32) * scale
        if log_forget_cum is not None:
            s = s + (log_forget_cum[:, :, q0:q1, None] - log_forget_cum[:, :, None, :q1])
        q_pos = q0 + jnp.arange(Q_BLOCK)
        k_pos = jnp.arange(q1)
        s = jnp.where(k_pos[None, :] <= q_pos[:, None], s, NEG_INF)
        p = jax.nn.softmax(s, axis=-1).astype(v.dtype)
        outs.append(jnp.einsum('bhqk,bhkd->bhqd', p, v[:, :, :q1]))
    return jnp.concatenate(outs, axis=2)


def mixer_sublayer(x, shift, scale, gate, cos, sin, g_pre, g_post, w_in, g_q_norm, w_uq,
                   g_kv_norm, w_ukv, b_forget, w_out):
    B, S, _ = x.shape
    h = rms_norm(x, g_pre) * (1 + scale[:, None, :]) + shift[:, None, :]
    proj = h @ w_in
    idx = [int(v) for v in np.cumsum(IN_SPLITS)[:-1]]
    cq, ckv, k_rope, fq, fk, fv, f_logit = jnp.split(proj, idx, axis=-1)

    q = (rms_norm(cq, g_q_norm) @ w_uq).reshape(B, S, MLA_HEADS, MLA_NOPE_DIM + MLA_ROPE_DIM)
    q_nope, q_rope = q[..., :MLA_NOPE_DIM], q[..., MLA_NOPE_DIM:]
    q_rope = apply_rope(q_rope, cos[:, :, None, :], sin[:, :, None, :])
    kv = (rms_norm(ckv, g_kv_norm) @ w_ukv).reshape(B, S, MLA_HEADS, MLA_NOPE_DIM + MLA_V_DIM)
    k_nope, v_m = kv[..., :MLA_NOPE_DIM], kv[..., MLA_NOPE_DIM:]
    k_rope = apply_rope(k_rope, cos, sin)
    k_m = jnp.concatenate(
        [k_nope, jnp.broadcast_to(k_rope[:, :, None, :], (B, S, MLA_HEADS, MLA_ROPE_DIM))], axis=-1)
    q_m = jnp.concatenate([q_nope, q_rope], axis=-1)
    o_mla = causal_block_attention(q_m.transpose(0, 2, 1, 3), k_m.transpose(0, 2, 1, 3),
                                   v_m.transpose(0, 2, 1, 3),
                                   1.0 / math.sqrt(MLA_NOPE_DIM + MLA_ROPE_DIM))

    def heads(t):
        return t.reshape(B, S, FOX_HEADS, FOX_HEAD_DIM).transpose(0, 2, 1, 3)
    log_f = jax.nn.log_sigmoid(f_logit.astype(jnp.float32) + b_forget.astype(jnp.float32))
    f_cum = jnp.cumsum(log_f, axis=1).transpose(0, 2, 1)
    o_fox = causal_block_attention(heads(fq), heads(fk), heads(fv),
                                   1.0 / math.sqrt(FOX_HEAD_DIM), f_cum)

    o = jnp.concatenate([o_mla.transpose(0, 2, 1, 3).reshape(B, S, MLA_HEADS * MLA_V_DIM),
                         o_fox.transpose(0, 2, 1, 3).reshape(B, S, FOX_WIDTH)], axis=-1)
    o = o @ w_out
    return x + gate[:, None, :] * rms_norm(o, g_post)


def moe_sublayer(x, shift, scale, gate, g_pre, g_post, w_router, b_router,
                 w_gate_up, b_gate_up, w_down, b_down):
    B, S, D = x.shape
    T = B * S
    h = rms_norm(x, g_pre) * (1 + scale[:, None, :]) + shift[:, None, :]
    xf = h.reshape(T, D)
    logits = (xf @ w_router + b_router).astype(jnp.float32)
    top_vals, top_idx = lax.top_k(logits, TOP_K)
    gates = jax.nn.softmax(top_vals, axis=-1)

    A = T * TOP_K
    e_flat = top_idx.reshape(A).astype(jnp.int32)
    tok_flat = (jnp.arange(A, dtype=jnp.int32) // TOP_K)
    g_flat = gates.reshape(A)
    order = jnp.argsort(e_flat)
    e_sorted = e_flat[order]
    counts = jnp.bincount(e_flat, length=N_EXPERTS).astype(jnp.int32)
    starts = jnp.cumsum(counts) - counts
    pcounts = ((counts + EXPERT_BLOCK - 1) // EXPERT_BLOCK) * EXPERT_BLOCK
    pends = jnp.cumsum(pcounts)
    pstarts = pends - pcounts
    dest = pstarts[e_sorted] + (jnp.arange(A, dtype=jnp.int32) - starts[e_sorted])
    n_blocks = -(-A // EXPERT_BLOCK) + N_EXPERTS
    P = n_blocks * EXPERT_BLOCK
    buf_tok = jnp.full((P,), T, dtype=jnp.int32).at[dest].set(tok_flat[order])
    buf_gate = jnp.zeros((P,), dtype=x.dtype).at[dest].set(g_flat[order].astype(x.dtype))
    block_expert = jnp.minimum(
        jnp.searchsorted(pends, jnp.arange(n_blocks, dtype=jnp.int32) * EXPERT_BLOCK, side='right'),
        N_EXPERTS - 1).astype(jnp.int32)
    x_pad = jnp.concatenate([xf, jnp.zeros((1, D), dtype=xf.dtype)], axis=0)

    def expert_block(args):
        tok_b, e = args
        xb = x_pad[tok_b]
        gu = xb @ w_gate_up[e] + b_gate_up[e]
        g, u = gu[:, :D_FF_EXPERT], gu[:, D_FF_EXPERT:]
        g = jnp.minimum(g, SWIGLU_LIMIT)
        u = jnp.clip(u, -SWIGLU_LIMIT, SWIGLU_LIMIT)
        glu = g * jax.nn.sigmoid(SWIGLU_ALPHA * g)
        return ((u + 1) * glu) @ w_down[e] + b_down[e]

    y = lax.map(expert_block, (buf_tok.reshape(n_blocks, EXPERT_BLOCK), block_expert))
    y = y.reshape(P, D) * buf_gate[:, None]
    out = jnp.zeros((T + 1, D), dtype=y.dtype).at[buf_tok].add(y)[:T].reshape(B, S, D)
    return x + gate[:, None, :] * rms_norm(out, g_post)


def setup_inputs(seed: int = 0) -> dict:
    key = jax.random.key(seed)
    ks = jax.random.split(key, 32)
    L, D, E, F = DEPTH, D_MODEL, N_EXPERTS, D_FF_EXPERT
    nrm = jax.random.normal

    def gain(k, n):
        return 1.0 + 0.05 * nrm(k, (L, n), jnp.float32)

    x = nrm(ks[0], (BATCH, SEQ, D), jnp.float32)
    c = nrm(ks[1], (BATCH, D), jnp.float32)
    offset = jax.random.randint(ks[2], (BATCH, 1), 0, 1024, dtype=jnp.int32)
    positions = offset + jnp.arange(SEQ, dtype=jnp.int32)[None, :]
    return {
        'x': x, 'c': c, 'positions': positions,
        'w_ada': nrm(ks[3], (L, D, 6 * D), jnp.float32) * D ** -0.5,
        'b_ada': 0.02 * nrm(ks[4], (L, 6 * D), jnp.float32),
        'g_attn_pre': gain(ks[5], D),
        'g_attn_post': gain(ks[6], D),
        'w_in': nrm(ks[7], (L, D, IN_WIDTH), jnp.float32) * D ** -0.5,
        'g_q_norm': gain(ks[8], MLA_Q_RANK),
        'w_uq': nrm(ks[9], (L, MLA_Q_RANK, MLA_HEADS * (MLA_NOPE_DIM + MLA_ROPE_DIM)), jnp.float32) * MLA_Q_RANK ** -0.5,
        'g_kv_norm': gain(ks[10], MLA_KV_RANK),
        'w_ukv': nrm(ks[11], (L, MLA_KV_RANK, MLA_HEADS * (MLA_NOPE_DIM + MLA_V_DIM)), jnp.float32) * MLA_KV_RANK ** -0.5,
        'b_forget': 3.0 + 0.5 * nrm(ks[12], (L, FOX_HEADS), jnp.float32),
        'w_out': nrm(ks[13], (L, MIX_WIDTH, D), jnp.float32) * MIX_WIDTH ** -0.5,
        'g_moe_pre': gain(ks[14], D),
        'g_moe_post': gain(ks[15], D),
        'w_router': nrm(ks[16], (L, D, E), jnp.float32) * D ** -0.5,
        'b_router': 0.01 * nrm(ks[17], (L, E), jnp.float32),
        'w_gate_up': nrm(ks[18], (L, E, D, 2 * F), jnp.float32) * D ** -0.5,
        'b_gate_up': 0.02 * nrm(ks[19], (L, E, 2 * F), jnp.float32),
        'w_down': nrm(ks[20], (L, E, F, D), jnp.float32) * F ** -0.5,
        'b_down': 0.02 * nrm(ks[21], (L, E, D), jnp.float32),
    }


def reference(x, c, positions, w_ada, b_ada, g_attn_pre, g_attn_post, w_in, g_q_norm, w_uq,
              g_kv_norm, w_ukv, b_forget, w_out, g_moe_pre, g_moe_post, w_router, b_router,
              w_gate_up, b_gate_up, w_down, b_down):
    cos, sin = rope_tables(positions)
    c_act = jax.nn.silu(c)
    for layer in range(DEPTH):
        ada = c_act @ w_ada[layer] + b_ada[layer]
        sh_a, sc_a, gt_a, sh_m, sc_m, gt_m = jnp.split(ada, 6, axis=-1)
        x = mixer_sublayer(x, sh_a, sc_a, gt_a, cos, sin, g_attn_pre[layer], g_attn_post[layer],
                           w_in[layer], g_q_norm[layer], w_uq[layer], g_kv_norm[layer],
                           w_ukv[layer], b_forget[layer], w_out[layer])
        x = moe_sublayer(x, sh_m, sc_m, gt_m, g_moe_pre[layer], g_moe_post[layer],
                         w_router[layer], b_router[layer], w_gate_up[layer], b_gate_up[layer],
                         w_down[layer], b_down[layer])
    return x
```

```cpp
#include <hip/hip_runtime.h>
#include <cstdio>
#include <cstdint>

#define GAS __attribute__((address_space(1)))
#define LAS __attribute__((address_space(3)))
typedef unsigned short bf16;
typedef float f32x4 __attribute__((ext_vector_type(4)));
typedef unsigned u32x4 __attribute__((ext_vector_type(4)));
typedef unsigned u32x2 __attribute__((ext_vector_type(2)));
typedef float f32x2v __attribute__((ext_vector_type(2)));

#ifndef PROBE_PHASE
#define PROBE_PHASE -1
#endif
#define REP(k) for (int rep_ = 0; rep_ < ((PROBE_PHASE) == (k) ? 2 : 1); ++rep_)
constexpr int NB = 8, SEQ = 4096, D = 1024, T = NB * SEQ;
constexpr int NE = 32, NA = T * 4;
constexpr int INW = 1960, PW = 2048;
constexpr int QW = 768, KVW = 1024;
constexpr float RMS_EPS = 1e-6f;
constexpr float LOG2E = 1.4426950408889634f;
constexpr float Y8_SCALE = 8.f;
constexpr float W8_SCALE = 64.f;
constexpr float C2F = 0.125f * LOG2E;
constexpr float C2M = 0.10206207261596577f * LOG2E;

constexpr size_t MiB = 1u << 20;
constexpr size_t WS_CTL = 0, CTL_ZERO_BYTES = 1 * MiB;
constexpr size_t WS_CS = 512 * 1024;
constexpr size_t WS_ADA = 1 * MiB;
constexpr size_t WS_COS = 2 * MiB, WS_SIN = 4 * MiB;
constexpr size_t WS_LF = 6 * MiB, WS_FT = 7 * MiB;
constexpr size_t WS_KB = 8 * MiB;
constexpr size_t WS_KR = 12 * MiB;
constexpr size_t WS_TOPE = 14 * MiB, WS_TOPG = 14 * MiB + 512 * 1024;
constexpr size_t WS_LIST = 812 * MiB;
constexpr size_t WS_WIN = 20 * MiB, WS_WUQ = 24 * MiB, WS_WUKV = 25 * MiB, WS_WOUT = 26 * MiB, WS_WGU = 28 * MiB, WS_WDN = 156 * MiB;
constexpr size_t WS_H = 220 * MiB;
constexpr size_t WS_PROJ = 284 * MiB;
constexpr size_t WS_CQN = 412 * MiB, WS_CKVN = 428 * MiB, WS_QM = 436 * MiB, WS_KV = 484 * MiB, WS_O = 548 * MiB, WS_OP = 612 * MiB;
constexpr size_t WS_ACT = 284 * MiB;
constexpr size_t WS_X1 = 700 * MiB;
constexpr size_t WS_Y = 556 * MiB;
constexpr size_t WS_END = 820 * MiB;
constexpr int CW_CNT = 64;
constexpr int CW_NRM = 2560;
constexpr int CW_Q = 3072;
constexpr int CW_BAR = 4096;

constexpr int LDS_BYTES = 147456;
constexpr int MISC_OFF = LDS_BYTES - 64;

__device__ __forceinline__ float bflo(unsigned u) { return __uint_as_float(u << 16); }
__device__ __forceinline__ float bfhi(unsigned u) { return __uint_as_float(u & 0xffff0000u); }
__device__ __forceinline__ float bf2f(bf16 b) { return __uint_as_float(((unsigned)b) << 16); }
__device__ __forceinline__ unsigned f2bf(float f) { unsigned u = __float_as_uint(f); return (u + 0x7fffu + ((u >> 16) & 1u)) >> 16; }
__device__ __forceinline__ unsigned pk2(float lo, float hi) { return f2bf(lo) | (f2bf(hi) << 16); }
__device__ __forceinline__ float wave_sum(float v) {
#pragma unroll
    for (int o = 1; o < 64; o <<= 1) v += __shfl_xor(v, o);
    return v;
}
__device__ __forceinline__ float wave_max(float v) {
#pragma unroll
    for (int o = 1; o < 64; o <<= 1) v = fmaxf(v, __shfl_xor(v, o));
    return v;
}
__host__ __device__ inline int inproj_src(int cp) {
    if (cp < 416) return cp;
    if (cp < 424) return 1952 + (cp - 416);
    if (cp < 512) return -1;
    if (cp < 1024) return 416 + (cp - 512);
    if (cp < 1536) return 928 + (cp - 1024);
    return 1440 + (cp - 1536);
}

#define XB_TMO      128
#define XB_XCNT(j)  (256  + 64 * (j))
#define XB_XSUB(j)  (1280 + 64 * (j))
#define XB_XGEN(j)  (2304 + 64 * (j))
#define XB_TOP      3328
#define XB_TOPGEN   3392
#define XCD_BAR_WORDS 3456
#define XB_SPIN_CAP (1u << 22)
__device__ __forceinline__ unsigned xb_ld(unsigned* p)              { return __hip_atomic_load(p, __ATOMIC_RELAXED, __HIP_MEMORY_SCOPE_AGENT); }
__device__ __forceinline__ unsigned xb_add(unsigned* p, unsigned v) { return __hip_atomic_fetch_add(p, v, __ATOMIC_RELAXED, __HIP_MEMORY_SCOPE_AGENT); }
__device__ __forceinline__ unsigned xb_xcc_id() { return (unsigned)__builtin_amdgcn_s_getreg((3 << 11) | 20) & 0xFu; }
#define XB_SPIN(cond, bar) do { unsigned _sp = 0; while (cond) { __builtin_amdgcn_s_sleep(1); \
    if ((++_sp & 255u) == 0u) { if (xb_ld(&(bar)[XB_TMO])) break; if (_sp > XB_SPIN_CAP) { atomicAdd(&(bar)[XB_TMO], 1u); break; } } } } while (0)
struct XcdBarrier { unsigned* bar; unsigned x; volatile LAS unsigned* st; };
__device__ __forceinline__ XcdBarrier xcd_barrier_post(unsigned* bar, volatile LAS unsigned* st) {
    XcdBarrier b; b.bar = bar; b.x = xb_xcc_id(); b.st = st;
    if (threadIdx.x == 0) (void)xb_add(&bar[XB_XCNT(b.x)], 1u);
    return b;
}
__device__ __forceinline__ void xcd_barrier_complete(unsigned* bar, unsigned x, unsigned& nloc, unsigned& nx) {
    const unsigned G = gridDim.x * gridDim.y * gridDim.z;
    unsigned sum, cnt, mine, sp = 0u;
    for (;;) {
        sum = 0u; cnt = 0u; mine = 0u;
#pragma unroll
        for (unsigned j = 0; j < 16; ++j) { const unsigned c = xb_ld(&bar[XB_XCNT(j)]); sum += c; cnt += (c > 0u) ? 1u : 0u; mine = (j == x) ? c : mine; }
        if (sum == G) break;
        __builtin_amdgcn_s_sleep(1);
        if ((++sp & 255u) == 0u) { if (xb_ld(&bar[XB_TMO])) break; if (sp > XB_SPIN_CAP) { atomicAdd(&bar[XB_TMO], 1u); break; } }
    }
    nloc = mine > 0u ? mine : 1u; nx = cnt > 0u ? cnt : 1u;
}
__device__ __forceinline__ void xcd_barrier(const XcdBarrier& b) {
    asm volatile("s_waitcnt vmcnt(0)" ::: "memory");
    __syncthreads();
    if (threadIdx.x == 0) {
        unsigned* bar = b.bar;
        __builtin_amdgcn_s_waitcnt(0);
        unsigned nloc = b.st[0], nx = b.st[1];
        if (nloc == 0u) { xcd_barrier_complete(bar, b.x, nloc, nx); b.st[0] = nloc; b.st[1] = nx; }
        const unsigned old = xb_add(&bar[XB_XSUB(b.x)], 1u);
        const unsigned gen = old / nloc;
        if (old + 1u == (gen + 1u) * nloc) {
            __builtin_amdgcn_fence(__ATOMIC_RELEASE, "agent");
            asm volatile("s_waitcnt vmcnt(0)" ::: "memory");
            const unsigned og = xb_add(&bar[XB_TOP], 1u);
            const unsigned tg = og / nx;
            if (og + 1u == (tg + 1u) * nx) xb_add(&bar[XB_TOPGEN], 1u);
            else XB_SPIN(xb_ld(&bar[XB_TOPGEN]) == tg, bar);
            __builtin_amdgcn_fence(__ATOMIC_ACQUIRE, "agent");
            xb_add(&bar[XB_XGEN(b.x)], 1u);
            asm volatile("s_waitcnt vmcnt(0)" ::: "memory");
        } else {
            XB_SPIN(xb_ld(&bar[XB_XGEN(b.x)]) == gen, bar);
            __builtin_amdgcn_fence(__ATOMIC_ACQUIRE, "agent");
            asm volatile("s_waitcnt vmcnt(0)" ::: "memory");
        }
    }
    __syncthreads();
}

struct Args { const void* in[22]; float* out; unsigned char* ws; };
enum { I_X = 0, I_C, I_POS, I_WADA, I_BADA, I_GAPRE, I_GAPOST, I_WIN, I_GQ, I_WUQ, I_GKV, I_WUKV, I_BF, I_WOUT, I_GMPRE, I_GMPOST, I_WR, I_BR, I_WGU, I_BGU, I_WDN, I_BDN };

namespace g8 {
typedef short bf16x8 __attribute__((ext_vector_type(8)));
constexpr int BM = 256, BK = 64, HALF = 128, HTB = HALF * BK * 2, STAGE_BYTES = 8 * HTB;
__host__ __device__ __forceinline__ int lds_byte(int r, int c) { const int st = (r >> 4) * 2 + (c >> 5), rr = r & 15, cc = c & 31, ob = rr * 64 + cc * 2; return st * 1024 + (ob ^ (((ob >> 9) & 1) << 5)); }
__host__ __device__ __forceinline__ void stage_rc(int b, int& R, int& C) { const int st = b / 1024, sb = b % 1024, swz = sb ^ (((sb >> 9) & 1) << 5); R = (st >> 1) * 16 + swz / 64; C = (st & 1) * 32 + (swz % 64) / 2; }
__host__ __device__ __forceinline__ int perm32(int rho) { const int n = rho >> 4, i = rho & 15; return 8 * (i >> 2) + 4 * n + (i & 3); }
__device__ __forceinline__ unsigned cvt_pk_bf16(float lo, float hi) { unsigned r; asm volatile("v_cvt_pk_bf16_f32 %0, %1, %2" : "=v"(r) : "v"(lo), "v"(hi)); return r; }

template <int OFF> __device__ __forceinline__ void glds16s(const char* sbase, unsigned voff, unsigned lds_w) {
    unsigned keep;
    asm volatile("s_mov_b32 %0, m0\n\ts_add_i32 m0, %3, %4\n\ts_nop 2\n\tglobal_load_lds_dwordx4 %1, %2\n\ts_mov_b32 m0, %0" : "=&s"(keep) : "v"(voff), "s"(sbase), "s"(lds_w), "n"(OFF) : "memory", "scc");
}
__device__ __forceinline__ const char* uni_ptr(const char* p) { const unsigned lo = __builtin_amdgcn_readfirstlane((unsigned)(uintptr_t)p), hi = __builtin_amdgcn_readfirstlane((unsigned)((uintptr_t)p >> 32)); return (const char*)(((uintptr_t)hi << 32) | (uintptr_t)lo); }
__device__ __forceinline__ void glds4s(const char* sbase, unsigned voff, unsigned lds_dst) {
    unsigned keep;
    asm volatile("s_mov_b32 %0, m0\n\ts_mov_b32 m0, %3\n\ts_nop 2\n\tglobal_load_lds_dword %1, %2\n\ts_mov_b32 m0, %0" : "=&s"(keep) : "v"(voff), "s"(sbase), "s"(lds_dst) : "memory");
}
struct Unit { const char* A; const char* B; int pm, pn, e, nv, rb, bs; };

typedef int i32x4v __attribute__((ext_vector_type(4)));
typedef int i32x8v __attribute__((ext_vector_type(8)));
__device__ __forceinline__ i32x8v cat8(bf16x8 lo, bf16x8 hi) { const i32x4v a = __builtin_bit_cast(i32x4v, lo), b = __builtin_bit_cast(i32x4v, hi); return __builtin_shufflevector(a, b, 0, 1, 2, 3, 4, 5, 6, 7); }
template <class Epi, class Sched, bool ALIGN_EPI, bool F8 = false>
__device__ __forceinline__ void gemm_phase(LAS unsigned char* lds, const int K, const Sched& S, const Epi& E) {
    int tid = threadIdx.x; asm volatile("" : "+v"(tid));
    const int wid = __builtin_amdgcn_readfirstlane(tid >> 6), lane = tid & 63, wr = wid >> 2, wc = wid & 3, fr = lane & 15, fq = lane >> 4;
    const int nt = K / BK;
    unsigned voffB[2];
#pragma unroll
    for (int i = 0; i < 2; ++i) { int R, C; stage_rc(tid * 16 + i * 8192, R, C); const int Rb = Epi::PERM ? ((R & ~31) + perm32(R & 31)) : R; voffB[i] = (unsigned)(Rb * K + C) * 2u; }
    const size_t kstep = (size_t)(BK * 2);
    const size_t hstep = (size_t)HALF * K * 2;
    const unsigned ldsW = (unsigned)__builtin_amdgcn_readfirstlane((unsigned)(uintptr_t)lds + (unsigned)wid * 1024u);
    const int aoff = lds_byte(wr * 64 + fr, fq * 8), boff = lds_byte(wc * 32 + fr, fq * 8);
#define G8_SA(b, h) (((b) * 2 + (h)) * HTB)
#define G8_SB(b, h) ((4 + (b) * 2 + (h)) * HTB)
#define G8_STAGE(bufoff, gbase, voff) do { glds16s<(bufoff)>((const char*)(gbase), (voff)[0], ldsW); glds16s<(bufoff) + 8192>((const char*)(gbase), (voff)[1], ldsW); } while (0)
#define G8_LD8(p) __builtin_shufflevector(*(const LAS i32x4v*)(p), *(const LAS i32x4v*)((p) + 1024), 0, 1, 2, 3, 4, 5, 6, 7)
#define G8_LDA(dst, b, h) do { _Pragma("unroll") for (int m = 0; m < 4; ++m) { if constexpr (F8) dst##8[m] = G8_LD8(lds + G8_SA(b, h) + aoff + m * 2048); \
        else { _Pragma("unroll") for (int k = 0; k < 2; ++k) dst[m][k] = *(const LAS bf16x8*)(lds + G8_SA(b, h) + aoff + m * 2048 + k * 1024); } } } while (0)
#define G8_LDB(dst, b, h) do { _Pragma("unroll") for (int n = 0; n < 2; ++n) { if constexpr (F8) dst##8[n] = G8_LD8(lds + G8_SB(b, h) + boff + n * 2048); \
        else { _Pragma("unroll") for (int k = 0; k < 2; ++k) dst[n][k] = *(const LAS bf16x8*)(lds + G8_SB(b, h) + boff + n * 2048 + k * 1024); } } } while (0)
#define G8_MMA(ai, bj, At, Bt) do { __builtin_amdgcn_s_setprio(1); _Pragma("unroll") for (int m = 0; m < 4; ++m) _Pragma("unroll") for (int n = 0; n < 2; ++n) { \
        if constexpr (F8) asm volatile("v_mfma_f32_16x16x128_f8f6f4 %0, %1, %2, %0" : "+v"(acc[ai][bj][m][n]) : "v"(Bt##8[n]), "v"(At##8[m]));   \
        else { _Pragma("unroll") for (int k = 0; k < 2; ++k) acc[ai][bj][m][n] = __builtin_amdgcn_mfma_f32_16x16x32_bf16(Bt[n][k], At[m][k], acc[ai][bj][m][n], 0, 0, 0); } } \
        __builtin_amdgcn_s_setprio(0); } while (0)
#define G8_WAIT_V(n) asm volatile("s_waitcnt vmcnt(" #n ")" ::: "memory")
#define G8_WAIT_L(n) asm volatile("s_waitcnt lgkmcnt(" #n ")" ::: "memory")
#define G8_BAR __builtin_amdgcn_s_barrier()
#define G8_SCHED __builtin_amdgcn_sched_barrier(0)
    Unit cur, nxt; int ui = 0;
    if (!S.next(0, cur)) return;
    cur.bs = 0;
    const unsigned ldsBias = (unsigned)__builtin_amdgcn_readfirstlane((unsigned)(uintptr_t)lds + 131072u + (unsigned)wid * 256u);
    f32x4 acc[2][2][4][2];
#pragma unroll
    for (int a = 0; a < 2; ++a)
#pragma unroll
        for (int b = 0; b < 2; ++b)
#pragma unroll
            for (int m = 0; m < 4; ++m)
#pragma unroll
                for (int n = 0; n < 2; ++n) { acc[a][b][m][n] = (f32x4){0.f, 0.f, 0.f, 0.f}; asm volatile("" : "+v"(acc[a][b][m][n])); }
    bf16x8 At[4][2], B0[2][2], B1[2][2]; i32x8v At8[4], B08[2], B18[2];
    unsigned cOff[2][2], nOff[2][2];
    S.aoffs(cur, tid, cOff);
    const char* cA = uni_ptr(cur.A); const char* cB = uni_ptr(cur.B);
#define G8_AH(base, h) (Sched::GATHER ? (base) : (base) + (h) * hstep)
#define G8_AO(off, h) (off)[Sched::GATHER ? (h) : 0]
    G8_STAGE(G8_SB(0, 0), cB, voffB); G8_STAGE(G8_SB(0, 1), cB + hstep, voffB); G8_STAGE(G8_SA(0, 0), G8_AH(cA, 0), G8_AO(cOff, 0)); G8_STAGE(G8_SA(0, 1), G8_AH(cA, 1), G8_AO(cOff, 1));
    if (wr == 1) G8_BAR;
    G8_WAIT_V(2); G8_BAR;
    G8_STAGE(G8_SB(1, 0), cB + kstep, voffB); G8_STAGE(G8_SA(1, 0), G8_AH(cA + kstep, 0), G8_AO(cOff, 0)); G8_STAGE(G8_SB(1, 1), cB + hstep + kstep, voffB);
    G8_WAIT_V(6); G8_BAR;
    for (;;) {
        const bool has_next = S.next(ui + 1, nxt);
        if constexpr (Epi::BIAS_LDS) { if (wid < 4) glds4s(uni_ptr((const char*)E.bias_src(cur, wid)), (unsigned)lane * 4u, ldsBias + (unsigned)cur.bs * 1024u); }
        if constexpr (Sched::GATHER) {
            if (has_next) S.aoffs(nxt, tid, nOff);
            else {
#pragma unroll
                for (int h = 0; h < 2; ++h)
#pragma unroll
                    for (int i = 0; i < 2; ++i) nOff[h][i] = cOff[h][i];
            }
        }
        const char* nA = uni_ptr(has_next ? nxt.A : cA); const char* nB = uni_ptr(has_next ? nxt.B : cB);
        for (int t = 0; t < nt; t += 2) {
            const bool last = (t == nt - 2);
            const char* a1 = cA + (size_t)(t + 1) * kstep;
            const char* a2 = last ? nA : cA + (size_t)(t + 2) * kstep; const char* b2 = last ? nB : cB + (size_t)(t + 2) * kstep;
            const char* a3 = a2 + kstep; const char* b3 = b2 + kstep;
            unsigned o2[2][2];
#pragma unroll
            for (int h = 0; h < 2; ++h)
#pragma unroll
                for (int i = 0; i < 2; ++i) o2[h][i] = (Sched::GATHER && last) ? nOff[h][i] : cOff[h][i];
            G8_LDB(B0, 0, 0); G8_LDB(B1, 0, 1); G8_SCHED; G8_LDA(At, 0, 0); G8_STAGE(G8_SA(1, 1), G8_AH(a1, 1), G8_AO(cOff, 1));
            G8_WAIT_V(8); G8_WAIT_L(0); G8_BAR; G8_MMA(0, 0, At, B0); G8_MMA(0, 1, At, B1); G8_BAR; G8_SCHED;
            G8_LDA(At, 0, 1); G8_STAGE(G8_SB(0, 0), b2, voffB); G8_STAGE(G8_SB(0, 1), b2 + hstep, voffB); G8_STAGE(G8_SA(0, 0), G8_AH(a2, 0), G8_AO(o2, 0));
            G8_WAIT_V(8); G8_WAIT_L(0); G8_BAR; G8_MMA(1, 0, At, B0); G8_MMA(1, 1, At, B1); G8_BAR; G8_SCHED;
            G8_LDB(B0, 1, 0); G8_LDB(B1, 1, 1); G8_SCHED; G8_LDA(At, 1, 0); G8_STAGE(G8_SA(0, 1), G8_AH(a2, 1), G8_AO(o2, 1));
            G8_WAIT_V(8); G8_WAIT_L(0); G8_BAR; G8_MMA(0, 0, At, B0); G8_MMA(0, 1, At, B1); G8_BAR; G8_SCHED;
            G8_LDA(At, 1, 1); G8_STAGE(G8_SB(1, 0), b3, voffB); G8_STAGE(G8_SB(1, 1), b3 + hstep, voffB); G8_STAGE(G8_SA(1, 0), G8_AH(a3, 0), G8_AO(o2, 0));
            G8_WAIT_V(8); G8_WAIT_L(0); G8_BAR; G8_MMA(1, 0, At, B0); G8_MMA(1, 1, At, B1); G8_BAR; G8_SCHED;
        }
        if constexpr (ALIGN_EPI) { if (wr == 0) G8_BAR; }
        if constexpr (F8) asm volatile("s_nop 15\n\ts_nop 7" ::: "memory");
        { int t2 = threadIdx.x; asm volatile("" : "+v"(t2)); E(acc, cur, wr, wc, t2 & 15, (t2 & 63) >> 4); }
        if (!has_next) break;
#pragma unroll
        for (int a = 0; a < 2; ++a)
#pragma unroll
            for (int b = 0; b < 2; ++b)
#pragma unroll
                for (int m = 0; m < 4; ++m)
#pragma unroll
                    for (int n = 0; n < 2; ++n) { acc[a][b][m][n] = (f32x4){0.f, 0.f, 0.f, 0.f}; asm volatile("" : "+v"(acc[a][b][m][n])); }
        cur = nxt; cA = nA; cB = nB; ++ui; cur.bs = ui & 1;
        if constexpr (Sched::GATHER) {
#pragma unroll
            for (int h = 0; h < 2; ++h)
#pragma unroll
                for (int i = 0; i < 2; ++i) cOff[h][i] = nOff[h][i];
        }
        if constexpr (ALIGN_EPI) { if (wr == 1) G8_BAR; }
    }
    G8_WAIT_V(0);
    if constexpr (!ALIGN_EPI) { if (wr == 0) G8_BAR; }
    G8_BAR;
#undef G8_SA
#undef G8_AH
#undef G8_AO
#undef G8_SB
#undef G8_STAGE
#undef G8_LDA
#undef G8_LD8
#undef G8_LDB
#undef G8_MMA
#undef G8_WAIT_V
#undef G8_WAIT_L
#undef G8_BAR
#undef G8_SCHED
}

constexpr int NXCD = 8, WGM = 8;
struct DenseSched {
    const char* A; const char* Bt; int K, nM, nN, nwg, G, c; bool spread = false;
    __device__ __forceinline__ void init(const void* A_, const void* Bt_, int M, int N, int K_, int G_, int c_) { A = (const char*)A_; Bt = (const char*)Bt_; K = K_; nM = M / BM; nN = N / BM; nwg = nM * nN; G = G_; c = c_; }
    __device__ __forceinline__ bool next(int i, Unit& u) const {
        if (spread && G == 256 && nM == 128 && nN == 8) {
            if (i >= 4) return false;
            const int x = c & 7, j = c >> 3;
            u.pm = 16 * x + 4 * i + (j >> 3); u.pn = ((j & 7) + 2 * i) & 7; u.e = 0; u.nv = 256; u.rb = u.pm * 256;
            u.A = A + (size_t)u.pm * 256 * K * 2; u.B = Bt + (size_t)u.pn * 256 * K * 2; return true;
        }
        const long L = (long)i * G + c; if (L >= nwg) return false;
        int wgid = (int)L; { const int q = nwg / NXCD, r = nwg % NXCD, xcd = wgid % NXCD, off = wgid / NXCD; wgid = (xcd < r ? xcd * (q + 1) : r * (q + 1) + (xcd - r) * q) + off; }
        const int nig = WGM * nN, gid = wgid / nig, fm = gid * WGM, gsz = (nM - fm) < WGM ? (nM - fm) : WGM;
        u.pm = fm + ((wgid % nig) % gsz); u.pn = (wgid % nig) / gsz; u.e = 0; u.nv = 256; u.rb = u.pm * 256;
        u.A = A + (size_t)u.pm * 256 * K * 2; u.B = Bt + (size_t)u.pn * 256 * K * 2; return true;
    }
    static constexpr bool GATHER = false;
    __device__ __forceinline__ void aoffs(const Unit&, int tid, unsigned (&off)[2][2]) const {
#pragma unroll
        for (int i = 0; i < 2; ++i) { int R, C; stage_rc(tid * 16 + i * 8192, R, C);
#pragma unroll
            for (int h = 0; h < 2; ++h) off[h][i] = (unsigned)((R * K + C) * 2); }
    }
};
template <bool GATHER_> struct MoeSched {
    static constexpr bool GATHER = GATHER_;
    int cntE, pendI, ebaseE, R, NT, G, c, K, lane; const char* Abase; const char* Wbase; size_t wstride; const int* LIST;
    __device__ __forceinline__ bool next(int i, Unit& u) const {
        int rtg, pn;
        if (G == 256) { const int x = c & 7, j = c >> 3, rpx = 32 / NT; rtg = (i * 8 + x) * rpx + j / NT; pn = j % NT; }
        else { const long L = (long)i * G + c; rtg = (int)(L / NT); pn = (int)(L % NT); }
        if (rtg >= R) return false;
        const int e = __popcll(__ballot(lane < 32 && pendI <= rtg));
        const int tstart = e > 0 ? __builtin_amdgcn_readlane(pendI, e - 1) : 0, rt = rtg - tstart, ne = __builtin_amdgcn_readlane(cntE, e), eb = __builtin_amdgcn_readlane(ebaseE, e);
        u.e = e; u.pm = rt; u.pn = pn; u.nv = (ne - 256 * rt) < 256 ? (ne - 256 * rt) : 256; u.rb = eb + 256 * rt;
        u.B = Wbase + (size_t)e * wstride + (size_t)pn * 256 * K * 2;
        u.A = GATHER ? Abase : Abase + (size_t)u.rb * K * 2;
        return true;
    }
    __device__ __forceinline__ void aoffs(const Unit& u, int tid, unsigned (&off)[2][2]) const {
#pragma unroll
        for (int i = 0; i < 2; ++i) { int R, C; stage_rc(tid * 16 + i * 8192, R, C);
#pragma unroll
            for (int h = 0; h < 2; ++h) {
                if (GATHER) { int r = h * HALF + R; r = r < u.nv ? r : u.nv - 1; const unsigned slot = ((const unsigned*)LIST)[2 * ((size_t)u.e * T + u.pm * 256 + r)]; unsigned tok = slot >> 2; tok = tok < (unsigned)T ? tok : (unsigned)(T - 1);
                    off[h][i] = tok * (unsigned)(K * 2) + (unsigned)(C * 2); }
                else off[h][i] = (unsigned)((R * K + C) * 2);
            } }
    }
};

struct EpiBf16Out {
    static constexpr bool PERM = true; static constexpr bool BIAS_LDS = false;
    bf16* O; int ldc; int sc_lo, sc_hi; float scale;
    __device__ __forceinline__ void operator()(const f32x4 (&acc)[2][2][4][2], const Unit& u, int wr, int wc, int fr, int fq) const {
        const int row0 = u.pm * BM + wr * 64 + fr, col0 = u.pn * BM + wc * 32 + 8 * fq;
        const float sc = (u.pn >= sc_lo && u.pn < sc_hi) ? scale : 1.f;
#pragma unroll
        for (int ai = 0; ai < 2; ++ai)
#pragma unroll
            for (int m = 0; m < 4; ++m) { bf16* rowp = O + (size_t)(row0 + ai * HALF + m * 16) * ldc + col0;
#pragma unroll
                for (int bj = 0; bj < 2; ++bj) { const f32x4 v0 = acc[ai][bj][m][0] * sc, v1 = acc[ai][bj][m][1] * sc;
                    u32x4 w; w.x = cvt_pk_bf16(v0[0], v0[1]); w.y = cvt_pk_bf16(v0[2], v0[3]); w.z = cvt_pk_bf16(v1[0], v1[1]); w.w = cvt_pk_bf16(v1[2], v1[3]);
                    *(u32x4*)(rowp + bj * HALF) = w; } }
    }
};
struct EpiProj {
    static constexpr bool PERM = true; static constexpr bool BIAS_LDS = false;
    bf16* O; unsigned* NRM;
    bf16* CQN; bf16* CKVN; bf16* KR; float* LF; float* CS; const float* COS; const float* SIN; const float* gq; const float* gkv; const float* bfg;
    LAS float* P;
    __device__ __forceinline__ void operator()(const f32x4 (&acc)[2][2][4][2], const Unit& u, int wr, int wc, int fr, int fq) const {
        if (u.pn < 2) {
            const int nbj = u.pn == 0 ? 2 : 1;
#pragma unroll
            for (int ai = 0; ai < 2; ++ai)
#pragma unroll
                for (int m = 0; m < 4; ++m) { float s = 0.f;
#pragma unroll
                    for (int bj = 0; bj < 2; ++bj) if (bj < nbj) {
#pragma unroll
                        for (int n = 0; n < 2; ++n) { const f32x4 v = acc[ai][bj][m][n]; s += (v[0] * v[0] + v[1] * v[1]) + (v[2] * v[2] + v[3] * v[3]); } }
                    s += __shfl_xor(s, 16); s += __shfl_xor(s, 32);
                    if (fq == 0) P[(ai * HALF + wr * 64 + m * 16 + fr) * 4 + wc] = s; }
            asm volatile("s_waitcnt lgkmcnt(0)\n\ts_barrier" ::: "memory");
            const float invn = u.pn == 0 ? 1.f / 256.f : 1.f / 128.f;
#pragma unroll
            for (int ai = 0; ai < 2; ++ai)
#pragma unroll
                for (int m = 0; m < 4; ++m) { const int row = ai * HALF + wr * 64 + m * 16 + fr; const size_t t = (size_t)u.pm * BM + row;
                    const f32x4 p = *(const LAS f32x4*)(P + row * 4); const float rstd = 1.f / sqrtf(((p[0] + p[1]) + (p[2] + p[3])) * invn + RMS_EPS);
#pragma unroll
                    for (int bj = 0; bj < 2; ++bj) if (bj < nbj) { const int col = bj * HALF + wc * 32 + 8 * fq; const float* gp = (u.pn == 0 ? gq : gkv) + col;
                        const f32x4 g0 = *(const f32x4*)gp, g1 = *(const f32x4*)(gp + 4); const f32x4 v0 = acc[ai][bj][m][0] * rstd * g0, v1 = acc[ai][bj][m][1] * rstd * g1;
                        u32x4 w; w.x = cvt_pk_bf16(v0[0], v0[1]); w.y = cvt_pk_bf16(v0[2], v0[3]); w.z = cvt_pk_bf16(v1[0], v1[1]); w.w = cvt_pk_bf16(v1[2], v1[3]);
                        if (u.pn == 0) *(u32x4*)(CQN + t * 256 + col) = w; else *(u32x4*)(CKVN + t * 128 + col) = w; } }
            if (u.pn == 1 && wc == 0) {
#pragma unroll
                for (int ai = 0; ai < 2; ++ai)
#pragma unroll
                    for (int m = 0; m < 4; ++m) { const size_t t = (size_t)u.pm * BM + ai * HALF + wr * 64 + m * 16 + fr;
                        const f32x4 cs0 = *(const f32x4*)(COS + t * 16 + 8 * (fq & 1)), cs1 = *(const f32x4*)(COS + t * 16 + 8 * (fq & 1) + 4), sn0 = *(const f32x4*)(SIN + t * 16 + 8 * (fq & 1)), sn1 = *(const f32x4*)(SIN + t * 16 + 8 * (fq & 1) + 4);
                        float o[8];
#pragma unroll
                        for (int n = 0; n < 2; ++n)
#pragma unroll
                            for (int i = 0; i < 4; ++i) { const float v = acc[ai][1][m][n][i], w = __shfl_xor(v, 32); const float cs = n ? cs1[i] : cs0[i], sn = n ? sn1[i] : sn0[i];
                                o[n * 4 + i] = fq < 2 ? v * cs - w * sn : w * sn + v * cs; }
                        u32x4 w; w.x = cvt_pk_bf16(o[0], o[1]); w.y = cvt_pk_bf16(o[2], o[3]); w.z = cvt_pk_bf16(o[4], o[5]); w.w = cvt_pk_bf16(o[6], o[7]);
                        *(u32x4*)(KR + t * 32 + 8 * fq) = w; }
            }
            if (u.pn == 1 && wc == 1) {
                const f32x4 b0 = *(const f32x4*)bfg, b1 = *(const f32x4*)(bfg + 4);
#pragma unroll
                for (int ai = 0; ai < 2; ++ai)
#pragma unroll
                    for (int m = 0; m < 4; ++m) { const size_t t = (size_t)u.pm * BM + ai * HALF + wr * 64 + m * 16 + fr; float lf[8];
#pragma unroll
                        for (int n = 0; n < 2; ++n)
#pragma unroll
                            for (int i = 0; i < 4; ++i) { const float z = acc[ai][1][m][n][i] + (n ? b1[i] : b0[i]);
                                float ls = fminf(z, 0.f) - __logf(1.f + __expf(-fabsf(z)));
#pragma unroll
                                for (int o2 = 1; o2 < 16; o2 <<= 1) { const float up = __shfl_up(ls, o2, 16); if (fr >= o2) ls += up; }
                                lf[n * 4 + i] = ls; }
                        if (fq == 0) { *(f32x4*)(LF + t * 8) = (f32x4){lf[0], lf[1], lf[2], lf[3]}; *(f32x4*)(LF + t * 8 + 4) = (f32x4){lf[4], lf[5], lf[6], lf[7]};
                            if (fr == 15) { float* c = CS + (t >> 4) * 8; *(f32x4*)c = (f32x4){lf[0], lf[1], lf[2], lf[3]}; *(f32x4*)(c + 4) = (f32x4){lf[4], lf[5], lf[6], lf[7]}; } } }
            }
            return;
        }
        const int row0 = u.pm * BM + wr * 64 + fr, col0 = u.pn * BM + wc * 32 + 8 * fq;
        const float sc = (u.pn == 2 || u.pn == 3) ? C2F : 1.f; const bool nrm = u.pn < 6;
        float mx[2] = {0.f, 0.f};
#pragma unroll
        for (int ai = 0; ai < 2; ++ai)
#pragma unroll
            for (int m = 0; m < 4; ++m) { bf16* rowp = O + (size_t)(row0 + ai * HALF + m * 16) * PW + col0;
#pragma unroll
                for (int bj = 0; bj < 2; ++bj) { const f32x4 v0 = acc[ai][bj][m][0] * sc, v1 = acc[ai][bj][m][1] * sc;
                    u32x4 w; w.x = cvt_pk_bf16(v0[0], v0[1]); w.y = cvt_pk_bf16(v0[2], v0[3]); w.z = cvt_pk_bf16(v1[0], v1[1]); w.w = cvt_pk_bf16(v1[2], v1[3]);
                    *(u32x4*)(rowp + bj * HALF) = w;
                    if (nrm) { float s = 0.f;
#pragma unroll
                        for (int i = 0; i < 4; ++i) { const unsigned ww = i == 0 ? w.x : i == 1 ? w.y : i == 2 ? w.z : w.w; const float lo = __uint_as_float(ww << 16), hi = __uint_as_float(ww & 0xffff0000u); s += lo * lo + hi * hi; }
                        s += __shfl_xor(s, 16); s += __shfl_xor(s, 32);
                        mx[bj] = fmaxf(mx[bj], s); } } }
        if (nrm) {
#pragma unroll
            for (int bj = 0; bj < 2; ++bj) { float v = mx[bj];
#pragma unroll
                for (int o = 1; o < 16; o <<= 1) v = fmaxf(v, __shfl_xor(v, o));
                if (fr == 0 && fq == 0) { const int kind = u.pn >= 4, head = (u.pn & 1) * 4 + bj * 2 + (wc >> 1), half = wc & 1, b = u.pm / (SEQ / BM);
                    __hip_atomic_fetch_max(NRM + ((kind * NB + b) * 8 + head) * 2 + half, __float_as_uint(v), __ATOMIC_RELAXED, __HIP_MEMORY_SCOPE_AGENT); } }
        }
    }
};
struct EpiQ {
    static constexpr bool PERM = false; static constexpr bool BIAS_LDS = false;
    bf16* QM; const float* COS; const float* SIN;
    __device__ __forceinline__ void operator()(const f32x4 (&acc)[2][2][4][2], const Unit& u, int wr, int wc, int fr, int fq) const {
#pragma unroll
        for (int bj = 0; bj < 2; ++bj) {
            const int c0 = u.pn * BM + bj * HALF + wc * 32; const bool rope = (c0 % 96) == 64;
#pragma unroll
            for (int ai = 0; ai < 2; ++ai)
#pragma unroll
                for (int m = 0; m < 4; ++m) { const int t = u.pm * BM + ai * HALF + wr * 64 + m * 16 + fr;
                    f32x4 x1 = acc[ai][bj][m][0], x2 = acc[ai][bj][m][1];
                    if (rope) { const f32x4 cs = *(const f32x4*)(COS + (size_t)t * 16 + 4 * fq), sn = *(const f32x4*)(SIN + (size_t)t * 16 + 4 * fq);
                        const f32x4 y1 = x1 * cs - x2 * sn, y2 = x1 * sn + x2 * cs; x1 = y1; x2 = y2; }
                    x1 = x1 * C2M; x2 = x2 * C2M;
                    bf16* p = QM + (size_t)t * QW + c0 + 4 * fq;
                    u32x2 w1, w2; w1.x = cvt_pk_bf16(x1[0], x1[1]); w1.y = cvt_pk_bf16(x1[2], x1[3]); w2.x = cvt_pk_bf16(x2[0], x2[1]); w2.y = cvt_pk_bf16(x2[2], x2[3]);
                    *(u32x2*)p = w1; *(u32x2*)(p + 16) = w2; }
        }
    }
};
__device__ __forceinline__ unsigned pk4_fp8(float a, float b, float c, float d) { unsigned w = 0; w = __builtin_amdgcn_cvt_pk_fp8_f32(a, b, w, false); w = __builtin_amdgcn_cvt_pk_fp8_f32(c, d, w, true); return w; }
__device__ __forceinline__ void st8x2_rows(unsigned char* base, size_t row_a, size_t row_b, bool ok_a, bool ok_b, int col0, int fq, u32x2 wa, u32x2 wb) {
    const bool odd = (fq & 1) != 0; const u32x2 send = odd ? wa : wb; u32x2 recv; recv.x = (unsigned)__shfl_xor((int)send.x, 16); recv.y = (unsigned)__shfl_xor((int)send.y, 16);
    u32x4 o; if (odd) { o.x = recv.x; o.y = recv.y; o.z = wb.x; o.w = wb.y; } else { o.x = wa.x; o.y = wa.y; o.z = recv.x; o.w = recv.y; }
    if (odd ? ok_b : ok_a) *(u32x4*)(base + (odd ? row_b : row_a) * D + col0 - (odd ? 8 : 0)) = o;
}
struct EpiGU8 {
    static constexpr bool PERM = true; static constexpr bool BIAS_LDS = true;
    unsigned char* ACT; const float* BG; float ws; const LAS float* BL;
    __device__ __forceinline__ const float* bias_src(const Unit& u, int j) const { return BG + (size_t)u.e * 2048 + (j >> 1) * 1024 + u.pn * 128 + (j & 1) * 64; }
    __device__ __forceinline__ void operator()(const f32x4 (&acc)[2][2][4][2], const Unit& u, int wr, int wc, int fr, int fq) const {
        const int f0 = u.pn * 128 + wc * 32 + 8 * fq; const LAS float* bp = BL + u.bs * 256 + wc * 32 + 8 * fq;
        const f32x4 bg0 = *(const LAS f32x4*)bp, bg1 = *(const LAS f32x4*)(bp + 4), bu0 = *(const LAS f32x4*)(bp + 128), bu1 = *(const LAS f32x4*)(bp + 132);
        u32x2 wv[2][4];
#pragma unroll
        for (int ai = 0; ai < 2; ++ai)
#pragma unroll
            for (int m = 0; m < 4; ++m) {
                float o[8];
#pragma unroll
                for (int n = 0; n < 2; ++n) { const f32x4 g4 = acc[ai][0][m][n] * ws + (n ? bg1 : bg0), u4 = acc[ai][1][m][n] * ws + (n ? bu1 : bu0);
#pragma unroll
                    for (int i = 0; i < 4; ++i) { const float gg = fminf(g4[i], 7.f), uu = fminf(fmaxf(u4[i], -7.f), 7.f);
                        const float sg = __builtin_amdgcn_rcpf(1.f + __builtin_amdgcn_exp2f(-1.702f * LOG2E * gg)); o[n * 4 + i] = (uu + 1.f) * gg * sg; } }
                wv[ai][m].x = pk4_fp8(o[0], o[1], o[2], o[3]); wv[ai][m].y = pk4_fp8(o[4], o[5], o[6], o[7]); }
#pragma unroll
        for (int ai = 0; ai < 2; ++ai)
#pragma unroll
            for (int m = 0; m < 4; m += 2) { const size_t ra = (size_t)(u.rb + ai * HALF + wr * 64 + m * 16 + fr); st8x2_rows(ACT, ra, ra + 16, true, true, f0, fq, wv[ai][m], wv[ai][m + 1]); }
    }
};
struct EpiDown {
    static constexpr bool PERM = true; static constexpr bool BIAS_LDS = true;
    unsigned char* Y; const float* BD; float ws; const LAS float* BL;
    __device__ __forceinline__ const float* bias_src(const Unit& u, int j) const { return BD + (size_t)u.e * D + u.pn * BM + j * 64; }
    __device__ __forceinline__ void operator()(const f32x4 (&acc)[2][2][4][2], const Unit& u, int wr, int wc, int fr, int fq) const {
        const int col0 = u.pn * BM + wc * 32 + 8 * fq; const LAS float* bp = BL + u.bs * 256 + wc * 32 + 8 * fq; const float s = ws * Y8_SCALE;
        f32x4 bv[2][2];
#pragma unroll
        for (int bj = 0; bj < 2; ++bj) { bv[bj][0] = *(const LAS f32x4*)(bp + bj * HALF) * Y8_SCALE; bv[bj][1] = *(const LAS f32x4*)(bp + bj * HALF + 4) * Y8_SCALE; }
#define Y8C(x) __builtin_amdgcn_fmed3f((x), -448.f, 448.f)
#pragma unroll
        for (int ai = 0; ai < 2; ++ai)
#pragma unroll
            for (int bj = 0; bj < 2; ++bj) { u32x2 wv[4];
#pragma unroll
                for (int m = 0; m < 4; ++m) { const f32x4 v0 = acc[ai][bj][m][0] * s + bv[bj][0], v1 = acc[ai][bj][m][1] * s + bv[bj][1];
                    wv[m].x = pk4_fp8(Y8C(v0[0]), Y8C(v0[1]), Y8C(v0[2]), Y8C(v0[3])); wv[m].y = pk4_fp8(Y8C(v1[0]), Y8C(v1[1]), Y8C(v1[2]), Y8C(v1[3])); }
#pragma unroll
                for (int m = 0; m < 4; m += 2) { const int r = ai * HALF + wr * 64 + m * 16 + fr;
                    st8x2_rows(Y, (size_t)(u.rb + r), (size_t)(u.rb + r + 16), r < u.nv, r + 16 < u.nv, col0 + bj * HALF, fq, wv[m], wv[m + 1]); } }
#undef Y8C
    }
};
}


namespace attn {
using bf16x8 = __attribute__((ext_vector_type(8))) short;
using s16x4 = __attribute__((ext_vector_type(4))) short;
using f32x16 = __attribute__((ext_vector_type(16))) float;
constexpr int SEQL = SEQ, NW = 8, QBLK = 32, QB = QBLK * NW, KVBLK = 64;
constexpr int NSLOT = 3, SLOTB = 12288;
constexpr int LDS_K = 0, LDS_V = NSLOT * SLOTB, LDS_WS = 2 * NSLOT * SLOTB, LDS_OST = LDS_WS + NW * 64 * 4, LDS_QX = LDS_OST + NW * 4096, LDS_BYTES = LDS_QX + NW * 2048;
__device__ __forceinline__ int crow(int r, int hi) { return (r & 3) + 8 * (r >> 2) + 4 * hi; }
#define SBAR() __builtin_amdgcn_sched_barrier(0)
__device__ __forceinline__ void cmask(f32x16& p0, f32x16& p1, int jb, int qrel, int hi) {
    const float NEG = -INFINITY; const int kb = 64 * jb + 4 * hi;
#pragma unroll
    for (int r = 0; r < 16; ++r) { const int kv = kb + (r & 3) + 8 * (r >> 2); if (kv > qrel) p0[r] = NEG; if (kv + 32 > qrel) p1[r] = NEG; }
}
__device__ __forceinline__ void glds16(const void* gsrc, unsigned lds_dst) { unsigned keep;
    asm volatile("s_mov_b32 %0, m0\n\ts_mov_b32 m0, %2\n\ts_nop 0\n\tglobal_load_lds_dwordx4 %1, off\n\ts_mov_b32 m0, %0" : "=&s"(keep) : "v"(gsrc), "s"(lds_dst) : "memory"); }
__device__ __forceinline__ void glds16u(const char* sbase, unsigned voff, unsigned lds_dst) { unsigned keep;
    asm volatile("s_mov_b32 %0, m0\n\ts_mov_b32 m0, %3\n\ts_nop 2\n\tglobal_load_lds_dwordx4 %1, %2\n\ts_mov_b32 m0, %0" : "=&s"(keep) : "v"(voff), "s"(sbase), "s"(lds_dst) : "memory"); }
__device__ __forceinline__ float max3f(float a, float b, float c) { float r; asm("v_max3_f32 %0, %1, %2, %3" : "=v"(r) : "v"(a), "v"(b), "v"(c)); return r; }
__device__ __forceinline__ float max2f(float a, float b) { float r; asm("v_max_f32_e32 %0, %1, %2" : "=v"(r) : "v"(a), "v"(b)); return r; }
__device__ __forceinline__ float fadd_s(float a, float b) { float r; asm("v_add_f32_e32 %0, %1, %2" : "=v"(r) : "v"(a), "v"(b)); return r; }
__device__ __forceinline__ float fsub_s(float a, float b) { float r; asm("v_sub_f32_e32 %0, %1, %2" : "=v"(r) : "v"(a), "v"(b)); return r; }
typedef float f32x2_t __attribute__((ext_vector_type(2))); typedef __bf16 bf16x2_t __attribute__((ext_vector_type(2)));
__device__ __forceinline__ unsigned cvtpk_s(float lo, float hi) { f32x2_t v = {lo, hi}; bf16x2_t b = __builtin_convertvector(v, bf16x2_t); return __builtin_bit_cast(unsigned, b); }
#define WAIT_BAR(N) asm volatile("s_waitcnt vmcnt(" #N ") lgkmcnt(0)\n\ts_barrier" ::: "memory")
typedef __attribute__((address_space(3))) const char* lds_cptr;
typedef short v4i16_t __attribute__((ext_vector_type(4)));
#define LDSF(p) (*(const __attribute__((address_space(3))) bf16x8*)(p))
__device__ __forceinline__ void kload2(bf16x8* kf, lds_cptr kp, int j) { kf[2 * j] = LDSF(kp + j * 2048); kf[2 * j + 1] = LDSF(kp + j * 2048 + 512); }
__device__ __forceinline__ s16x4 vtr(lds_cptr p) { return __builtin_bit_cast(s16x4, __builtin_amdgcn_ds_read_tr16_b64_v4i16((__attribute__((address_space(3))) v4i16_t*)p)); }
__device__ __forceinline__ float rowmax(const f32x16& p0, const f32x16& p1) {
    float a = max3f(p0[0], p0[1], p1[0]), b = max3f(p0[2], p0[3], p1[1]); a = max3f(a, p1[2], p1[3]);
#pragma unroll
    for (int r = 4; r < 16; r += 4) { a = max3f(a, p0[r], p0[r + 1]); b = max3f(b, p0[r + 2], p0[r + 3]); a = max3f(a, p1[r], p1[r + 1]); b = max3f(b, p1[r + 2], p1[r + 3]); }
    const float m = max2f(a, b);
    auto rr = __builtin_amdgcn_permlane32_swap(__float_as_uint(m), __float_as_uint(m), false, false);
    return max2f(__uint_as_float(rr[0]), __uint_as_float(rr[1]));
}
__device__ __forceinline__ void pv(f32x16* o, int vb, bf16x8 pa0, bf16x8 pa1, bf16x8 pa2, bf16x8 pa3) {
#pragma unroll
    for (int d0 = 0; d0 < 2; ++d0) { s16x4 lo[4], hi[4];
#pragma unroll
        for (int ks = 0; ks < 4; ++ks) {
            asm volatile("ds_read_b64_tr_b16 %0,%1 offset:%c2" : "=&v"(lo[ks]) : "v"(vb), "i"(d0 * 4096 + ks * 1024) : "memory");
            asm volatile("ds_read_b64_tr_b16 %0,%1 offset:%c2" : "=&v"(hi[ks]) : "v"(vb), "i"(d0 * 4096 + ks * 1024 + 512) : "memory"); }
        asm volatile("s_waitcnt lgkmcnt(0)" ::: "memory"); SBAR();
#define PK(k) (bf16x8){lo[k][0], lo[k][1], lo[k][2], lo[k][3], hi[k][0], hi[k][1], hi[k][2], hi[k][3]}
        o[d0] = __builtin_amdgcn_mfma_f32_32x32x16_bf16(pa0, PK(0), o[d0], 0, 0, 0);
        o[d0] = __builtin_amdgcn_mfma_f32_32x32x16_bf16(pa1, PK(1), o[d0], 0, 0, 0);
        o[d0] = __builtin_amdgcn_mfma_f32_32x32x16_bf16(pa2, PK(2), o[d0], 0, 0, 0);
        o[d0] = __builtin_amdgcn_mfma_f32_32x32x16_bf16(pa3, PK(3), o[d0], 0, 0, 0);
#undef PK
    }
}
#define MF32(a, b, c) __builtin_amdgcn_mfma_f32_32x32x16_bf16(a, b, c, 0, 0, 0)

__device__ __forceinline__ float fox_prepass(int b, int h, int qb, unsigned char* ws, char* shm) {
    int tid = threadIdx.x; asm volatile("" : "+v"(tid));
    const int lane = tid & 63, r32 = lane & 31, hi = lane >> 5; const int wid = __builtin_amdgcn_readfirstlane(tid >> 6);
    const long rowbase = (long)b * SEQL; const int tw0 = qb * QB + wid * QBLK;
    const bf16* Qg = (const bf16*)(ws + WS_PROJ) + 512 + h * 64; const bf16* Kg = (const bf16*)(ws + WS_PROJ) + 1024 + h * 64; const bf16* Xg = (const bf16*)(ws + WS_KB) + h * 8;
    bf16x8 qr[4];
#pragma unroll
    for (int d0 = 0; d0 < 4; ++d0) qr[d0] = *reinterpret_cast<const bf16x8*>(&Qg[(rowbase + tw0 + r32) * PW + d0 * 16 + hi * 8]);
    const short one_ = hi ? (short)0 : (short)0x3F80; const bf16x8 qfox = (bf16x8){one_, one_, one_, 0, 0, 0, 0, 0};
    float rmax = -INFINITY;
#pragma unroll
    for (int kt = 0; kt < 3; ++kt) {
        const int k0 = tw0 - 64 + 32 * kt; int key = k0 + r32; key = key < 0 ? 0 : key;
        const bf16* kp = Kg + (rowbase + key) * PW + hi * 8;
        f32x16 sc = f32x16{};
#pragma unroll
        for (int d0 = 0; d0 < 4; ++d0) sc = MF32(*reinterpret_cast<const bf16x8*>(kp + d0 * 16), qr[d0], sc);
        sc = MF32(*reinterpret_cast<const bf16x8*>(Xg + (rowbase + key) * 64), qfox, sc);
#pragma unroll
        for (int r = 0; r < 16; ++r) { const int kk = k0 + crow(r, hi); rmax = __builtin_fmaxf(rmax, (kk >= 0 && kk <= tw0 + r32) ? sc[r] : -INFINITY); }
    }
    rmax = __builtin_fmaxf(rmax, __shfl_xor(rmax, 32));
    float v = rmax;
#pragma unroll
    for (int o = 16; o >= 1; o >>= 1) v = __builtin_fminf(v, __shfl_xor(v, o));
    float* wsall = (float*)(shm + LDS_WS);
    if (lane == 0) wsall[wid * 64] = v;
    __syncthreads();
    float g = wsall[0];
#pragma unroll
    for (int w = 1; w < NW; ++w) g = __builtin_fminf(g, wsall[w * 64]);
    __syncthreads();
    return -g;
}

template <bool MLA, int THRL>
__device__ __forceinline__ void attn_unit(int b, int h, int qb, unsigned char* ws, char* shm, int n0 = 0) {
    constexpr int QP = MLA ? QW : PW, KP = MLA ? KVW : PW, VP = KP, XP = MLA ? 32 : 64, NXS = MLA ? 2 : 1, NXW = MLA ? 4 : 1;
    int tid = threadIdx.x; asm volatile("" : "+v"(tid));
    const int lane = tid & 63, r32 = lane & 31, hi = lane >> 5; const int wid = __builtin_amdgcn_readfirstlane(tid >> 6);
    const long rowbase = (long)b * SEQL; const int q0 = qb * QB;
    const bf16* Qb = MLA ? (const bf16*)(ws + WS_QM) + h * 96 : (const bf16*)(ws + WS_PROJ) + 512 + h * 64;
    const bf16* Kb = MLA ? (const bf16*)(ws + WS_KV) + h * 128 : (const bf16*)(ws + WS_PROJ) + 1024 + h * 64;
    const bf16* Vb = MLA ? (const bf16*)(ws + WS_KV) + h * 128 + 64 : (const bf16*)(ws + WS_PROJ) + 1536 + h * 64;
    const bf16* Xb = MLA ? (const bf16*)(ws + WS_KR) : (const bf16*)(ws + WS_KB) + h * 8;
    const bf16* Qw = Qb + (rowbase + q0 + wid * QBLK) * QP;
    const unsigned lds0 = (unsigned)(uintptr_t)shm; const lds_cptr shm3 = (lds_cptr)shm;
    float* wsf = (float*)(shm + LDS_WS) + wid * 64;
    const unsigned kvoff = (unsigned)((lane * KP + wid * 8) * 2);
    const unsigned vvoff = (unsigned)(((16 * (wid & 3) + (lane >> 2)) * VP + (wid >> 2) * 32 + (lane & 3) * 8) * 2);
    const unsigned xvoff = (unsigned)((lane * XP + (MLA ? wid * 8 : 0)) * 2);
    const long kr0 = rowbase + (long)n0 * KVBLK;
    const char* kbase = g8::uni_ptr((const char*)(Kb + kr0 * KP)); const char* vbase = g8::uni_ptr((const char*)(Vb + kr0 * VP)); const char* xbase = g8::uni_ptr((const char*)(Xb + kr0 * XP));
    const unsigned kdst = lds0 + LDS_K + wid * 1024, vdst = lds0 + LDS_V + wid * 1024, xdst = lds0 + LDS_K + 8192 + wid * 1024;
#define DMA_K(t, slot) glds16u(g8::uni_ptr(kbase + (size_t)(t) * (KVBLK * KP * 2)), kvoff, (unsigned)__builtin_amdgcn_readfirstlane(kdst + (slot)))
#define DMA_V(t, slot) glds16u(g8::uni_ptr(vbase + (size_t)(t) * (KVBLK * VP * 2)), vvoff, (unsigned)__builtin_amdgcn_readfirstlane(vdst + (slot)))
#define DMA_X(t, slot) do { if (wid < NXW) glds16u(g8::uni_ptr(xbase + (size_t)(t) * (KVBLK * XP * 2)), xvoff, (unsigned)__builtin_amdgcn_readfirstlane(xdst + (slot))); } while (0)
    const int vb0 = (int)(lds0 + LDS_V) + ((lane >> 4) & 1) * 32 + (lane & 3) * 8 + (4 * hi + ((lane & 15) >> 2)) * 64;
    const char* Kbase = shm + LDS_K; bf16x8 kf[8];
    const lds_cptr kp0 = shm3 + LDS_K + hi * 1024 + r32 * 16;
    const lds_cptr kxp0 = shm3 + LDS_K + 8192 + (MLA ? hi * 1024 : 0) + r32 * 16;
    const lds_cptr vp0 = shm3 + LDS_V + ((lane >> 4) & 1) * 32 + (lane & 3) * 8 + (4 * hi + ((lane & 15) >> 2)) * 64;
    const int NT = (q0 + QB) / KVBLK - n0;
    DMA_K(0, 0); DMA_X(0, 0); DMA_V(0, 0); DMA_K(1, SLOTB); DMA_X(1, SLOTB);
    bf16x8 qr[4];
#pragma unroll
    for (int d0 = 0; d0 < 4; ++d0) qr[d0] = *reinterpret_cast<const bf16x8*>(&Qw[(long)r32 * QP + d0 * 16 + hi * 8]);
    const lds_cptr qxp = shm3 + LDS_QX + wid * 2048 + hi * 512 + r32 * 16;
    if (MLA) {
#pragma unroll
        for (int xs = 0; xs < NXS; ++xs) { const bf16x8 v = *reinterpret_cast<const bf16x8*>(&Qw[(long)r32 * QP + 64 + xs * 16 + hi * 8]);
            *(__attribute__((address_space(3))) bf16x8*)(shm3 + LDS_QX + wid * 2048 + xs * 1024 + hi * 512 + r32 * 16) = v; }
    }
    const short one_ = hi ? (short)0 : (short)0x3F80; const bf16x8 qfox = (bf16x8){one_, one_, one_, 0, 0, 0, 0, 0};
#define QX(xs) (MLA ? LDSF(qxp + (xs) * 1024) : qfox)
    const float ft = MLA ? 0.f : ((const float*)(ws + WS_FT))[(rowbase + q0 + wid * QBLK + r32) * 8 + h];
    float mhat = 0.f, l_reg = 0.f; f32x16 o[2]; o[0] = f32x16{}; o[1] = f32x16{}; f32x16 negm;
#pragma unroll
    for (int r = 0; r < 16; ++r) negm[r] = ft;
    asm volatile("" : "+v"(negm));
    const int qrel = wid * QBLK + r32;
#define CMASK(P0, P1, t) do { int jb_ = (t) - (NT - 4); if (jb_ >= 0) cmask(P0, P1, jb_, qrel, hi); } while (0)
    bool resc = false;
#define START(P0, P1) do { const float rm = rowmax(P0, P1); resc = false; \
    { const float dl = MLA ? rm : (__any(rm > (float)THRL) ? __builtin_fmaxf(rm, 0.f) : 0.f);     \
      mhat = fadd_s(mhat, dl); \
      _Pragma("unroll") for (int r = 0; r < 16; ++r) { P0[r] = fsub_s(P0[r], dl); P1[r] = fsub_s(P1[r], dl); } \
      _Pragma("unroll") for (int r = 0; r < 16; ++r) negm[r] = ft - mhat; asm volatile("" : "+v"(negm)); } \
    _Pragma("unroll") for (int r = 0; r < 16; ++r) P0[r] = __builtin_amdgcn_exp2f(P0[r]); } while (0)
#define RESC() do { if (resc) { asm volatile("s_waitcnt lgkmcnt(0)" ::: "memory"); \
      _Pragma("unroll") for (int d_ = 0; d_ < 2; ++d_) _Pragma("unroll") for (int r = 0; r < 16; ++r) o[d_][r] *= wsf[crow(r, hi)]; } } while (0)
    f32x16 pA0, pA1, pB0, pB1;
    int sl_prev = 0, sl_cur = 0, sl_next = SLOTB;
#define ROT() do { sl_prev = sl_cur; sl_cur = sl_next; sl_next = (sl_next == (NSLOT - 1) * SLOTB) ? 0 : sl_next + SLOTB; } while (0)
    DMA_K(2, 2 * SLOTB); DMA_X(2, 2 * SLOTB);
    WAIT_BAR(0);
    { bf16x8 kx[2 * NXS];
      const char* kb = Kbase + hi * 1024 + r32 * 16;
#pragma unroll
      for (int d0 = 0; d0 < 4; ++d0) {
          const bf16x8 b0 = *reinterpret_cast<const bf16x8*>(kb + d0 * 2048);
          const bf16x8 b1 = *reinterpret_cast<const bf16x8*>(kb + d0 * 2048 + 512);
          if (d0 == 0) { pA0 = MF32(b0, qr[0], negm); pA1 = MF32(b1, qr[0], negm); }
          else { pA0 = MF32(b0, qr[d0], pA0); pA1 = MF32(b1, qr[d0], pA1); } }
#pragma unroll
      for (int xs = 0; xs < NXS; ++xs) { kx[2 * xs] = LDSF(kxp0 + xs * 2048); kx[2 * xs + 1] = LDSF(kxp0 + xs * 2048 + 512);
          const bf16x8 qq = QX(xs); pA0 = MF32(kx[2 * xs], qq, pA0); pA1 = MF32(kx[2 * xs + 1], qq, pA1); } }
    asm volatile("s_nop 15\n\ts_nop 7" : "+v"(pA0), "+v"(pA1)); CMASK(pA0, pA1, 0);
    START(pA0, pA1);
    _Pragma("unroll") for (int r = 0; r < 16; ++r) pA1[r] = __builtin_amdgcn_exp2f(pA1[r]);
    WAIT_BAR(0);
    DMA_K(3, 0); DMA_V(1, SLOTB);
    ROT();
    { _Pragma("unroll") for (int j = 0; j < 4; ++j) kload2(kf, kp0 + sl_cur, j); }
    WAIT_BAR(2);
    s16x4 vlo[8], vhi[8]; u32x4 pw0, pw1, pw2, pw3;
#define PKW(P, B) cvtpk_s(P[B], P[B + 1])
#define PAF(k) __builtin_bit_cast(bf16x8, pw##k)
#define VFR(i) (bf16x8){vlo[i][0], vlo[i][1], vlo[i][2], vlo[i][3], vhi[i][0], vhi[i][1], vhi[i][2], vhi[i][3]}
#define PIN(x) asm volatile("" : "+v"(x))
#define MX3(a, b, c) __builtin_fmaxf(__builtin_fmaxf((a), (b)), (c))
#define GAPA(MFX, A0, A1, A2, A3, W0, W1, PW) do { MFX; sacc += A0; sacc += A1; sacc += A2; sacc += A3; PIN(sacc); W0; W1; PIN(PW); SBAR(); } while (0)
#define EX(v) __builtin_amdgcn_exp2f(v)
#define GAPB(MFX, X, B) do { MFX; X[B] = EX(X[B]); X[B + 1] = EX(X[B + 1]); X[B + 2] = EX(X[B + 2]); X[B + 3] = EX(X[B + 3]); PIN(X); SBAR(); } while (0)
#define VRD(i) do { vlo[i] = vtr(vp_ + (((i) >> 2) * 4096 + ((i) & 3) * 1024)); vhi[i] = vtr(vp_ + (((i) >> 2) * 4096 + ((i) & 3) * 1024 + 512)); } while (0)
#define KRD(G, j) do { if (G) { kload2(kf, kp0 + sl_next, j); SBAR(); } } while (0)
#define STEP(C0, C1, P0, P1, t, GX, GK, GV, GL) do { SBAR(); \
    if (GX) { DMA_X((t) + 2, sl_prev); } \
    const lds_cptr vp_ = vp0 + sl_prev; const lds_cptr kxp_ = kxp0 + sl_cur; bf16x8 kx[2 * NXS]; \
    VRD(0); SBAR(); float sacc = (P0[0] + P0[1]); \
    GAPA(C0 = MF32(kf[0], qr[0], negm), P0[2], P0[3], P0[4], P0[5],     pw0[0] = PKW(P0, 0), pw0[1] = PKW(P0, 2), pw0); \
    VRD(4); SBAR(); GAPA(C1 = MF32(kf[1], qr[0], negm), P0[6], P0[7], P0[8], P0[9],     pw0[2] = PKW(P0, 4), pw0[3] = PKW(P0, 6), pw0); \
    VRD(1); SBAR(); GAPA(C0 = MF32(kf[2], qr[1], C0),   P0[10], P0[11], P0[12], P0[13], pw1[0] = PKW(P0, 8), pw1[1] = PKW(P0, 10), pw1); \
    VRD(5); SBAR(); GAPA(C1 = MF32(kf[3], qr[1], C1),   P0[14], P0[15], P1[0], P1[1],   pw1[2] = PKW(P0, 12), pw1[3] = PKW(P0, 14), pw1); \
    kx[0] = LDSF(kxp_); kx[1] = LDSF(kxp_ + 512); SBAR(); \
    VRD(2); SBAR(); GAPA(C0 = MF32(kf[4], qr[2], C0),   P1[2], P1[3], P1[4], P1[5],     pw2[0] = PKW(P1, 0), pw2[1] = PKW(P1, 2), pw2); \
    VRD(6); SBAR(); GAPA(C1 = MF32(kf[5], qr[2], C1),   P1[6], P1[7], P1[8], P1[9],     pw2[2] = PKW(P1, 4), pw2[3] = PKW(P1, 6), pw2); \
    if (NXS > 1) { kx[2 * (NXS - 1)] = LDSF(kxp_ + 2048); kx[2 * (NXS - 1) + 1] = LDSF(kxp_ + 2048 + 512); SBAR(); } \
    VRD(3); SBAR(); GAPA(C0 = MF32(kf[6], qr[3], C0),   P1[10], P1[11], P1[12], P1[13], pw3[0] = PKW(P1, 8), pw3[1] = PKW(P1, 10), pw3); \
    VRD(7); SBAR(); GAPA(C1 = MF32(kf[7], qr[3], C1),   P1[14], P1[15], 0.f, 0.f,       pw3[2] = PKW(P1, 12), pw3[3] = PKW(P1, 14), pw3); \
    { const bf16x8 qq = QX(0); C0 = MF32(kx[0], qq, C0); SBAR(); C1 = MF32(kx[1], qq, C1); SBAR(); } \
    if (NXS > 1) { const bf16x8 qq = QX(NXS - 1); C0 = MF32(kx[2 * (NXS - 1)], qq, C0); SBAR(); C1 = MF32(kx[2 * (NXS - 1) + 1], qq, C1); SBAR(); } \
    l_reg += sacc; \
    if (GK) { DMA_K((t) + 3, sl_cur); } if (GV) { DMA_V((t) + 1, sl_next); } \
    CMASK(C0, C1, t); \
    { float a = MX3(C0[0], C0[1], C1[0]), b_ = MX3(C0[2], C0[3], C1[1]); a = MX3(a, C1[2], C1[3]); \
      _Pragma("unroll") for (int r = 4; r < 16; r += 4) { a = MX3(a, C0[r], C0[r + 1]); b_ = MX3(b_, C0[r + 2], C0[r + 3]); a = MX3(a, C1[r], C1[r + 1]); b_ = MX3(b_, C1[r + 2], C1[r + 3]); } \
      float rm = __builtin_fmaxf(a, b_); { auto rr = __builtin_amdgcn_permlane32_swap(__float_as_uint(rm), __float_as_uint(rm), false, false); rm = __builtin_fmaxf(__uint_as_float(rr[0]), __uint_as_float(rr[1])); } \
      resc = false; \
      if (__builtin_expect(__any(rm > (float)THRL), 0)) { const float dl = __builtin_fmaxf(rm, 0.f); mhat += dl; \
        _Pragma("unroll") for (int r = 0; r < 16; ++r) { C0[r] -= dl; C1[r] -= dl; } \
        _Pragma("unroll") for (int r = 0; r < 16; ++r) negm[r] = ft - mhat; asm volatile("" : "+v"(negm)); \
        const float f = __builtin_amdgcn_exp2f(-dl); l_reg *= f; if (hi == 0) wsf[r32] = f; resc = true; } } \
    SBAR(); \
    GAPB(o[0] = MF32(PAF(0), VFR(0), o[0]), C0, 0); \
    GAPB(o[1] = MF32(PAF(0), VFR(4), o[1]), C0, 4); \
    KRD(GL, 0); GAPB(o[0] = MF32(PAF(1), VFR(1), o[0]), C0, 8); \
    KRD(GL, 1); GAPB(o[1] = MF32(PAF(1), VFR(5), o[1]), C0, 12); \
    KRD(GL, 2); GAPB(o[0] = MF32(PAF(2), VFR(2), o[0]), C1, 0); \
    KRD(GL, 3); GAPB(o[1] = MF32(PAF(2), VFR(6), o[1]), C1, 4); \
    GAPB(o[0] = MF32(PAF(3), VFR(3), o[0]), C1, 8); \
    GAPB(o[1] = MF32(PAF(3), VFR(7), o[1]), C1, 12); \
    } while (0)
    int t = 1;
#undef CMASK
#define CMASK(P0, P1, t) do { } while (0)
    for (; t + 5 < NT; t += 2) {
        STEP(pB0, pB1, pA0, pA1, t, true, true, true, true);     WAIT_BAR(2); RESC(); ROT();
        STEP(pA0, pA1, pB0, pB1, t + 1, true, true, true, true); WAIT_BAR(2); RESC(); ROT();
    }
#undef CMASK
#define CMASK(P0, P1, t) do { int jb_ = (t) - (NT - 4); if (jb_ >= 0) cmask(P0, P1, jb_, qrel, hi); } while (0)
#define ENDW(tt) do { if ((tt) + 3 < NT) { WAIT_BAR(2); } else if ((tt) + 2 < NT) { WAIT_BAR(1); } else { WAIT_BAR(0); } } while (0)
    for (; t + 1 < NT; t += 2) {
        STEP(pB0, pB1, pA0, pA1, t, (t + 2 < NT), (t + 3 < NT), (t + 1 < NT), (t + 1 < NT));         ENDW(t);     RESC(); ROT();
        STEP(pA0, pA1, pB0, pB1, t + 1, (t + 3 < NT), (t + 4 < NT), (t + 2 < NT), (t + 2 < NT));     ENDW(t + 1); RESC(); ROT();
    }
    STEP(pB0, pB1, pA0, pA1, NT - 1, false, false, false, false); RESC();
    { float sacc = pB0[0] + pB0[1];
      _Pragma("unroll") for (int r = 2; r < 16; ++r) sacc += pB0[r];
      _Pragma("unroll") for (int r = 0; r < 16; ++r) sacc += pB1[r];
      l_reg += sacc;
      pw0 = (u32x4){PKW(pB0, 0), PKW(pB0, 2), PKW(pB0, 4), PKW(pB0, 6)}; pw1 = (u32x4){PKW(pB0, 8), PKW(pB0, 10), PKW(pB0, 12), PKW(pB0, 14)};
      pw2 = (u32x4){PKW(pB1, 0), PKW(pB1, 2), PKW(pB1, 4), PKW(pB1, 6)}; pw3 = (u32x4){PKW(pB1, 8), PKW(pB1, 10), PKW(pB1, 12), PKW(pB1, 14)};
      SBAR(); pv(o, vb0 + sl_cur, PAF(0), PAF(1), PAF(2), PAF(3)); }
#undef PKW
#undef PAF
#undef VFR
#undef PIN
#undef MX3
#undef GAPA
#undef GAPB
#undef EX
#undef VRD
#undef KRD
#undef STEP
#undef ENDW
    { auto rr = __builtin_amdgcn_permlane32_swap(__float_as_uint(l_reg), __float_as_uint(l_reg), false, false); l_reg = __uint_as_float(rr[0]) + __uint_as_float(rr[1]); }
    if (hi == 0) wsf[32 + r32] = l_reg; asm volatile("s_waitcnt lgkmcnt(0)" ::: "memory");
    float rli[16];
#pragma unroll
    for (int r = 0; r < 16; ++r) rli[r] = __builtin_amdgcn_rcpf(wsf[32 + crow(r, hi)]);
    bf16* Ow = (bf16*)(ws + WS_O) + (rowbase + q0 + wid * QBLK) * D + (MLA ? 0 : 512) + h * 64;
    { bf16* stg = (bf16*)(shm + LDS_OST) + wid * 2048;
#pragma unroll
      for (int r = 0; r < 16; ++r) { const int orow = crow(r, hi);
#pragma unroll
          for (int d0 = 0; d0 < 2; ++d0) stg[orow * 64 + d0 * 32 + r32] = (bf16)f2bf(o[d0][r] * rli[r]); }
      asm volatile("s_waitcnt lgkmcnt(0)" ::: "memory");
#pragma unroll
      for (int i = 0; i < 4; ++i) { const int row = i * 8 + (lane >> 3), ch = lane & 7; const u32x4 v = *(const u32x4*)(stg + row * 64 + ch * 8); *(u32x4*)(Ow + (long)row * D + ch * 8) = v; } }
    asm volatile("s_waitcnt lgkmcnt(0)\n\ts_barrier" ::: "memory");
#undef DMA_K
#undef DMA_V
#undef DMA_X
#undef QX
#undef CMASK
#undef START
#undef RESC
#undef ROT
}
#undef SBAR
#undef WAIT_BAR
#undef LDSF
#undef MF32
}

template <class MapF>
__device__ __forceinline__ void transpose_item(const float* W, int K, int ldw, bf16* WT, LAS float* scr, int item, int nblk, int lane, MapF map) {
    const int kb = item / nblk, nb = item % nblk, k0 = 64 * kb, n0 = 32 * nb;
    const int src = map(n0 + (lane & 31)); const float* wp = W + (src < 0 ? 0 : src); const float wsc = src < 0 ? 0.f : 1.f;
#pragma unroll
    for (int i = 0; i < 32; ++i) { const int kk = 2 * i + (lane >> 5); scr[kk * 33 + (lane & 31)] = wp[(size_t)(k0 + kk) * ldw] * wsc; }
    asm volatile("s_waitcnt lgkmcnt(0)" ::: "memory");
    const int c = lane & 7;
#pragma unroll
    for (int j = 0; j < 4; ++j) { const int n = (lane >> 3) + 8 * j; const LAS float* s = scr + (8 * c) * 33 + n;
        u32x4 o; o.x = pk2(s[0 * 33], s[1 * 33]); o.y = pk2(s[2 * 33], s[3 * 33]); o.z = pk2(s[4 * 33], s[5 * 33]); o.w = pk2(s[6 * 33], s[7 * 33]);
        *(u32x4*)(WT + (size_t)(n0 + n) * K + k0 + 8 * c) = o; }
    asm volatile("s_waitcnt lgkmcnt(0)" ::: "memory");
}

struct TItem { bf16* WT; int K, k0, n0; float wsc; bool valid; };
template <typename MapF>
__device__ __forceinline__ void titem_load(const float* W, int K, int ldw, bf16* WT, int item, int nblk, int lane, MapF map, float (&tv)[32], TItem& ti) {
    const int kb = item / nblk, nb = item % nblk, k0 = 64 * kb, n0 = 32 * nb;
    const int src = map(n0 + (lane & 31)); const float* wp = W + (src < 0 ? 0 : src);
    ti.WT = WT; ti.K = K; ti.k0 = k0; ti.n0 = n0; ti.wsc = src < 0 ? 0.f : 1.f; ti.valid = true;
#pragma unroll
    for (int i = 0; i < 32; ++i) { const int kk = 2 * i + (lane >> 5); tv[i] = wp[(size_t)(k0 + kk) * ldw]; }
}
__device__ __forceinline__ void titem_finish(const float (&tv)[32], const TItem& ti, LAS float* scr, int lane) {
#pragma unroll
    for (int i = 0; i < 32; ++i) { const int kk = 2 * i + (lane >> 5); scr[kk * 33 + (lane & 31)] = tv[i] * ti.wsc; }
    asm volatile("s_waitcnt lgkmcnt(0)" ::: "memory");
    const int c = lane & 7;
#pragma unroll
    for (int j = 0; j < 4; ++j) { const int n = (lane >> 3) + 8 * j; const LAS float* q = scr + (8 * c) * 33 + n;
        u32x4 o; o.x = pk2(q[0 * 33], q[1 * 33]); o.y = pk2(q[2 * 33], q[3 * 33]); o.z = pk2(q[4 * 33], q[5 * 33]); o.w = pk2(q[6 * 33], q[7 * 33]);
        *(u32x4*)(ti.WT + (size_t)(ti.n0 + n) * ti.K + ti.k0 + 8 * c) = o; }
    asm volatile("s_waitcnt lgkmcnt(0)" ::: "memory");
}
__device__ __forceinline__ void f8x_item(const float* Wsrc, int ldw, unsigned char* WTdst, LAS unsigned char* tile, int lane, float sc) {
    const int nq = lane & 31, kr = lane >> 5;
    const float* wp = Wsrc + (size_t)(4 * kr) * ldw + 4 * nq;
    f32x4 va[4][4], vb[4][4];
#define F8X_LOAD(v, g2) do { _Pragma("unroll") for (int q = 0; q < 4; ++q) _Pragma("unroll") for (int j = 0; j < 4; ++j) v[q][j] = __builtin_nontemporal_load((const f32x4*)(wp + (size_t)(8 * ((g2) + q) + j) * ldw)); } while (0)
#define F8X_PACK(v, g2) do { _Pragma("unroll") for (int q = 0; q < 4; ++q) { const int kd = 2 * ((g2) + q) + kr; _Pragma("unroll") for (int c = 0; c < 4; ++c) \
        *(LAS unsigned*)(tile + (4 * nq + c) * 128 + 16 * ((kd >> 2) ^ (nq & 7)) + 4 * (kd & 3)) = g8::pk4_fp8(v[q][0][c] * sc, v[q][1][c] * sc, v[q][2][c] * sc, v[q][3][c] * sc); } } while (0)
    F8X_LOAD(va, 0); __builtin_amdgcn_sched_barrier(0);
    F8X_LOAD(vb, 4); __builtin_amdgcn_sched_barrier(0);
    F8X_PACK(va, 0); __builtin_amdgcn_sched_barrier(0);
    F8X_LOAD(va, 8); __builtin_amdgcn_sched_barrier(0);
    F8X_PACK(vb, 4); __builtin_amdgcn_sched_barrier(0);
    F8X_LOAD(vb, 12); __builtin_amdgcn_sched_barrier(0);
    F8X_PACK(va, 8); __builtin_amdgcn_sched_barrier(0);
    F8X_PACK(vb, 12);
#undef F8X_LOAD
#undef F8X_PACK
    asm volatile("s_waitcnt lgkmcnt(0)" ::: "memory");
    const int c8 = lane & 7;
#pragma unroll 4
    for (int jj = 0; jj < 16; ++jj) { const int n = (lane >> 3) + 8 * jj;
        const u32x4 o = *(const LAS u32x4*)(tile + n * 128 + 16 * (c8 ^ ((n >> 2) & 7)));
        __builtin_nontemporal_store(o, (u32x4*)(WTdst + (size_t)n * 1024 + 16 * c8)); }
    asm volatile("s_waitcnt lgkmcnt(0)" ::: "memory");
}
template <class MapF>
__device__ __forceinline__ void transpose_item_f8(const float* W, int K, int ldw, unsigned char* WT, LAS float* scr, int item, int nblk, int lane, float sc, MapF map) {
    const int kb = item / nblk, nb = item % nblk, k0 = 128 * kb, n0 = 32 * nb;
    const int src = map(n0 + (lane & 31)); const float* wp = W + src;
#pragma unroll 8
    for (int i = 0; i < 64; ++i) { const int kk = 2 * i + (lane >> 5); scr[kk * 33 + (lane & 31)] = __builtin_nontemporal_load(wp + (size_t)(k0 + kk) * ldw) * sc; }
    asm volatile("s_waitcnt lgkmcnt(0)" ::: "memory");
    const int c = lane & 7;
#pragma unroll
    for (int j = 0; j < 4; ++j) { const int n = (lane >> 3) + 8 * j; const LAS float* s = scr + (16 * c) * 33 + n;
        u32x4 o; o.x = g8::pk4_fp8(s[0 * 33], s[1 * 33], s[2 * 33], s[3 * 33]); o.y = g8::pk4_fp8(s[4 * 33], s[5 * 33], s[6 * 33], s[7 * 33]);
        o.z = g8::pk4_fp8(s[8 * 33], s[9 * 33], s[10 * 33], s[11 * 33]); o.w = g8::pk4_fp8(s[12 * 33], s[13 * 33], s[14 * 33], s[15 * 33]);
        __builtin_nontemporal_store(o, (u32x4*)(WT + (size_t)(n0 + n) * K + k0 + 16 * c)); }
    asm volatile("s_waitcnt lgkmcnt(0)" ::: "memory");
}

__device__ __forceinline__ void dephase(int n) { for (int i = 0; i < n; ++i) __builtin_amdgcn_s_sleep(1); }
__global__ void __launch_bounds__(512, 2) fwd(Args a) {
    extern __shared__ __attribute__((aligned(16))) unsigned char lds_raw[];
    LAS unsigned char* lds = (LAS unsigned char*)lds_raw;
    const int G = gridDim.x, NGW = G * 8;
    unsigned char* ws = a.ws;
    unsigned* ctl = (unsigned*)(ws + WS_CTL);
    volatile LAS unsigned* MISC = (volatile LAS unsigned*)(lds + MISC_OFF);
    if (threadIdx.x < 16) MISC[threadIdx.x] = 0u;
    __syncthreads();
#define PH_IDS int tid = threadIdx.x; asm volatile("" : "+v"(tid)); const int lane = tid & 63; const int wave = __builtin_amdgcn_readfirstlane(tid >> 6); const int gw = blockIdx.x * 8 + wave; (void)lane; (void)wave; (void)gw;
    XcdBarrier bar = xcd_barrier_post(ctl + CW_BAR, MISC);

#define XIN ((const float*)a.in[I_X])
#define ADA ((float*)(ws + WS_ADA))
#define COS ((float*)(ws + WS_COS))
#define SIN ((float*)(ws + WS_SIN))
#define LF ((float*)(ws + WS_LF))
#define FT ((float*)(ws + WS_FT))
#define KB ((bf16*)(ws + WS_KB))
#define KR ((bf16*)(ws + WS_KR))
#define TOPE ((int*)(ws + WS_TOPE))
#define TOPG ((float*)(ws + WS_TOPG))
#define LIST ((int*)(ws + WS_LIST))
#define H ((bf16*)(ws + WS_H))
#define PROJ ((bf16*)(ws + WS_PROJ))
#define CQN ((bf16*)(ws + WS_CQN))
#define CKVN ((bf16*)(ws + WS_CKVN))
#define QM ((bf16*)(ws + WS_QM))
#define KV ((bf16*)(ws + WS_KV))
#define O ((bf16*)(ws + WS_O))
#define OP ((bf16*)(ws + WS_OP))
#define ACT ((bf16*)(ws + WS_ACT))
#define Y ((bf16*)(ws + WS_Y))

    REP(0)
    {
        PH_IDS
        const float* c = (const float*)a.in[I_C]; const float* w = (const float*)a.in[I_WADA]; const float* bias = (const float*)a.in[I_BADA];
        LAS float* cact = (LAS float*)lds; LAS float* red = (LAS float*)(lds + 32768);
        __syncthreads();
        { float cv[16];
#pragma unroll
          for (int i = 0; i < 16; ++i) cv[i] = c[tid + 512 * i];
#pragma unroll
          for (int i = 0; i < 16; ++i) cact[tid + 512 * i] = cv[i] / (1.f + expf(-cv[i])); }
        __syncthreads();
        for (int cb = blockIdx.x; cb < 192; cb += G) {
            const int cc = tid & 31, ks = tid >> 5, col = cb * 32 + cc;
            const float bsv = tid < 256 ? bias[cb * 32 + (tid & 31)] : 0.f;
            float acc[8];
#pragma unroll
            for (int b = 0; b < 8; ++b) acc[b] = 0.f;
#pragma unroll
            for (int i = 0; i < 64; ++i) { const int k = ks * 64 + i; const float wv = __builtin_nontemporal_load(w + (size_t)k * 6144 + col);
#pragma unroll
                for (int b = 0; b < 8; ++b) acc[b] += cact[b * 1024 + k] * wv; }
#pragma unroll
            for (int b = 0; b < 8; ++b) red[(ks * 8 + b) * 32 + cc] = acc[b];
            __syncthreads();
            if (tid < 256) { const int b = tid >> 5, c2 = tid & 31; float s = bsv;
                for (int k2 = 0; k2 < 16; ++k2) s += red[(k2 * 8 + b) * 32 + c2];
                ADA[b * 6144 + cb * 32 + c2] = s; }
            __syncthreads();
        }
    }
    xcd_barrier(bar);

    REP(1)
    {
        PH_IDS
        const float* g = (const float*)a.in[I_GAPRE];
        constexpr int I_IN = 16 * 64, I_UQ = 4 * 24, I_UKV = 2 * 32, I_OUT = 16 * 32;
        constexpr int NIT = I_IN + I_UQ + I_UKV + I_OUT;
        LAS float* scr = (LAS float*)(lds + wave * 17408);
        float tv[32]; TItem ti; ti.valid = false; ti.WT = nullptr; ti.K = 0; ti.k0 = 0; ti.n0 = 0; ti.wsc = 0.f;
        const int* pos = (const int*)a.in[I_POS]; const int ib0 = blockIdx.x * 512 + tid; int pv0[4];
#pragma unroll
        for (int q = 0; q < 4; ++q) { const int i = ib0 + q * G * 512; pv0[q] = i < T * 16 ? pos[i >> 4] : 0; }
        if (gw < NIT) {
            int r = gw;
            if (r < I_IN) titem_load((const float*)a.in[I_WIN], 1024, INW, (bf16*)(ws + WS_WIN), r, 64, lane, [](int n) { return inproj_src(n); }, tv, ti);
            else if ((r -= I_IN) < I_UQ) titem_load((const float*)a.in[I_WUQ], 256, QW, (bf16*)(ws + WS_WUQ), r, 24, lane, [](int n) { return n; }, tv, ti);
            else if ((r -= I_UQ) < I_UKV) titem_load((const float*)a.in[I_WUKV], 128, KVW, (bf16*)(ws + WS_WUKV), r, 32, lane, [](int n) { return n; }, tv, ti);
            else { r -= I_UKV; titem_load((const float*)a.in[I_WOUT], 1024, D, (bf16*)(ws + WS_WOUT), r, 32, lane, [](int n) { return n; }, tv, ti); }
        }
        for (int ch = gw; ch < T / 16; ch += NGW) {
            const int t0 = ch * 16, b = t0 / SEQ; const float* sh = ADA + b * 6144; const float* sc = sh + 1024;
            f32x4 gs[4], hs[4];
#pragma unroll
            for (int j = 0; j < 4; ++j) { gs[j] = ((const f32x4*)g)[lane + 64 * j] * (((const f32x4*)sc)[lane + 64 * j] + 1.f); hs[j] = ((const f32x4*)sh)[lane + 64 * j]; }
            for (int i = 0; i < 16; i += 4) {
                f32x4 v[4][4];
#pragma unroll
                for (int r = 0; r < 4; ++r)
#pragma unroll
                    for (int j = 0; j < 4; ++j) v[r][j] = __builtin_nontemporal_load((const f32x4*)(XIN + (size_t)(t0 + i + r) * D) + lane + 64 * j);
#pragma unroll
                for (int r = 0; r < 4; ++r) { float s = 0.f;
#pragma unroll
                    for (int j = 0; j < 4; ++j) s += v[r][j].x * v[r][j].x + v[r][j].y * v[r][j].y + v[r][j].z * v[r][j].z + v[r][j].w * v[r][j].w;
                    const float rstd = 1.f / sqrtf(wave_sum(s) * (1.f / D) + RMS_EPS);
                    u32x2* o8 = (u32x2*)(H + (size_t)(t0 + i + r) * D) + lane;
#pragma unroll
                    for (int j = 0; j < 4; ++j) { const f32x4 q = v[r][j] * rstd * gs[j] + hs[j]; u32x2 o; o.x = pk2(q.x, q.y); o.y = pk2(q.z, q.w); o8[64 * j] = o; } }
            }
        }
        if (ti.valid) titem_finish(tv, ti, scr, lane);
        for (int it = gw + NGW; it < NIT; it += NGW) {
            int r = it;
            if (r < I_IN) { transpose_item((const float*)a.in[I_WIN], 1024, INW, (bf16*)(ws + WS_WIN), scr, r, 64, lane, [](int n) { return inproj_src(n); }); continue; } r -= I_IN;
            if (r < I_UQ) { transpose_item((const float*)a.in[I_WUQ], 256, QW, (bf16*)(ws + WS_WUQ), scr, r, 24, lane, [](int n) { return n; }); continue; } r -= I_UQ;
            if (r < I_UKV) { transpose_item((const float*)a.in[I_WUKV], 128, KVW, (bf16*)(ws + WS_WUKV), scr, r, 32, lane, [](int n) { return n; }); continue; } r -= I_UKV;
            transpose_item((const float*)a.in[I_WOUT], 1024, D, (bf16*)(ws + WS_WOUT), scr, r, 32, lane, [](int n) { return n; });
        }
        for (int ib = blockIdx.x * 512 + tid; ib < T * 16; ib += 4 * G * 512) {
            int pv[4];
#pragma unroll
            for (int q = 0; q < 4; ++q) { const int i = ib + q * G * 512; pv[q] = ib == ib0 ? pv0[q] : (i < T * 16 ? pos[i >> 4] : 0); }
#pragma unroll
            for (int q = 0; q < 4; ++q) { const int i = ib + q * G * 512;
                if (i < T * 16) { const int j = i & 15;
                    float inv = 1.f;
                    { constexpr float INVF[16] = {1.0f, 0.5623413324356079f, 0.3162277638912201f, 0.17782793939113617f, 0.10000000149011612f, 0.05623413249850273f, 0.03162277489900589f, 0.017782794311642647f, 0.009999999776482582f, 0.005623413249850273f, 0.003162277629598975f, 0.0017782794311642647f, 0.0010000000474974513f, 0.000562341301701963f, 0.0003162277571391314f, 0.00017782794020604342f};
#pragma unroll
                      for (int z = 0; z < 16; ++z) inv = j == z ? INVF[z] : inv; }
                    const float ang = (float)pv[q] * inv;
                    const double ad = (double)ang; const double n = rint(ad * 0.15915494309189535); const float r = (float)(ad - n * 6.283185307179586);
                    COS[i] = cosf(r); SIN[i] = sinf(r); } }
        }
    }
    xcd_barrier(bar);

    REP(2)
    {
        g8::DenseSched S; S.init(H, ws + WS_WIN, T, PW, D, G, (int)blockIdx.x); S.spread = true;
        g8::EpiProj E{PROJ, ctl + CW_NRM, CQN, CKVN, KR, LF, (float*)(ws + WS_CS), COS, SIN, (const float*)a.in[I_GQ], (const float*)a.in[I_GKV], (const float*)a.in[I_BF], (LAS float*)(lds + 131072)};
        g8::gemm_phase<g8::EpiProj, g8::DenseSched, true>(lds, D, S, E);
    }
    xcd_barrier(bar);

    { PH_IDS
      LAS float* pre = (LAS float*)lds; const float* CS = (const float*)(ws + WS_CS);
      for (int sq = (G >= 192 ? (int)blockIdx.x - 128 : (int)blockIdx.x); sq < 64; sq += G) {
        if (sq < 0) break;
        const int b = sq >> 3, h = sq & 7;
        float lf[SEQ / 512];
#pragma unroll
        for (int k = 0; k < SEQ / 512; ++k) lf[k] = LF[((size_t)b * SEQ + tid + 512 * k) * 8 + h];
        if (wave == 0) {
            float c[4], s = 0.f;
#pragma unroll
            for (int j = 0; j < 4; ++j) { c[j] = CS[(size_t)(b * 256 + 4 * lane + j) * 8 + h]; s += c[j]; }
            float incl = s;
#pragma unroll
            for (int o = 1; o < 64; o <<= 1) { const float u = __shfl_up(incl, o); if (lane >= o) incl += u; }
            float e0 = incl - s;
#pragma unroll
            for (int j = 0; j < 4; ++j) { pre[4 * lane + j] = e0; e0 += c[j]; }
        }
        __syncthreads();
#pragma unroll
        for (int k = 0; k < SEQ / 512; ++k) { const int i = tid + 512 * k; const size_t idx = ((size_t)b * SEQ + i) * 8 + h; const float f2 = (lf[k] + pre[i >> 4]) * LOG2E; FT[idx] = f2;
            const float nf = -f2; const unsigned hi = f2bf(nf); const float r1 = nf - __uint_as_float(hi << 16); const unsigned mid = f2bf(r1); const float r2 = r1 - __uint_as_float(mid << 16); const unsigned lo = f2bf(r2);
            u32x4 o; o.x = hi | (mid << 16); o.y = lo; o.z = 0u; o.w = 0u; *(u32x4*)(KB + idx * 8) = o; }
        __syncthreads();
      }
    }

    __syncthreads();
    REP(4) {
    {
        g8::DenseSched S; S.init(CQN, ws + WS_WUQ, T, QW, 256, G, (int)blockIdx.x);
        g8::EpiQ E{QM, COS, SIN};
        g8::gemm_phase<g8::EpiQ, g8::DenseSched, true>(lds, 256, S, E);
    }
    {
        g8::DenseSched S; S.init(CKVN, ws + WS_WUKV, T, KVW, 128, G, (int)blockIdx.x);
        g8::EpiBf16Out E{KV, KVW, 0, 0, 1.f};
        g8::gemm_phase<g8::EpiBf16Out, g8::DenseSched, true>(lds, 128, S, E);
    }
    }
    xcd_barrier(bar);

    REP(5)
    {
        PH_IDS
        const int xg = blockIdx.x & 7, jg = blockIdx.x >> 3, nj = G >> 3, ncvj = nj > 8 ? 4 : 1;
        if (jg >= nj - ncvj || G < 8) {
            const int ncw = (G < 8 ? G : ncvj * 8) * 8, cw = (G < 8 ? (int)blockIdx.x : (jg - (nj - ncvj)) * 8 + xg) * 8 + wave;
            LAS unsigned char* tile = (LAS unsigned char*)(lds + wave * 17408);
            for (int it = cw; it < NE * 192; it += ncw) {
                const int e = it / 192; int r = it - e * 192;
                if (r < 128) { const int nb = r & 15, kb = r >> 4, n0 = 128 * nb, srcc = ((n0 >> 7) & 1) * 1024 + (n0 >> 8) * 128;
                    f8x_item((const float*)a.in[I_WGU] + (size_t)e * 1024 * 2048 + (size_t)(128 * kb) * 2048 + srcc, 2048, ws + WS_WGU + (size_t)e * 2048 * 1024 + (size_t)n0 * 1024 + 128 * kb, tile, lane, W8_SCALE); }
                else { r -= 128; const int nb = r & 7, kb = r >> 3, n0 = 128 * nb;
                    f8x_item((const float*)a.in[I_WDN] + (size_t)e * 1024 * 1024 + (size_t)(128 * kb) * 1024 + n0, 1024, ws + WS_WDN + (size_t)e * 1024 * 1024 + (size_t)n0 * 1024 + 128 * kb, tile, lane, W8_SCALE); }
            }
            __syncthreads();
        }
        {
          const unsigned* NRM = ctl + CW_NRM; const float* FTp = (const float*)(ws + WS_FT);
          for (int xq = xg;;) {
            float BqL = 0.f;
            if (lane < 8) {
                const float qn = __uint_as_float(__hip_atomic_load(NRM + ((0 * NB + xq) * 8 + lane) * 2, __ATOMIC_RELAXED, __HIP_MEMORY_SCOPE_AGENT)) + __uint_as_float(__hip_atomic_load(NRM + ((0 * NB + xq) * 8 + lane) * 2 + 1, __ATOMIC_RELAXED, __HIP_MEMORY_SCOPE_AGENT));
                const float kn = __uint_as_float(__hip_atomic_load(NRM + ((1 * NB + xq) * 8 + lane) * 2, __ATOMIC_RELAXED, __HIP_MEMORY_SCOPE_AGENT)) + __uint_as_float(__hip_atomic_load(NRM + ((1 * NB + xq) * 8 + lane) * 2 + 1, __ATOMIC_RELAXED, __HIP_MEMORY_SCOPE_AGENT));
                BqL = sqrtf(qn * kn) * 1.02f + 4.f; }
            unsigned popped = 0;
            if (tid == 0) popped = __hip_atomic_fetch_add(ctl + CW_Q + 64 * xq, 1u, __ATOMIC_RELAXED, __HIP_MEMORY_SCOPE_AGENT);
            for (;;) {
                if (tid == 0) MISC[4] = popped;
                __syncthreads();
                const int idx = __builtin_amdgcn_readfirstlane((int)MISC[4]);
                __syncthreads();
                if (idx >= 256) break;
                if (tid == 0) popped = __hip_atomic_fetch_add(ctl + CW_Q + 64 * xq, 1u, __ATOMIC_RELAXED, __HIP_MEMORY_SCOPE_AGENT);
                const int qb = 15 - ((idx & 127) >> 3), h = idx & 7;
                if (idx < 128) { attn::attn_unit<true, 8>(xq, h, qb, ws, (char*)lds_raw); continue; }
                const int NTf = 4 * qb + 4; const long rowbase = (long)xq * SEQ;
                const float Bq = __builtin_amdgcn_readlane(BqL, h);
                const float Gp = qb > 0 ? attn::fox_prepass(xq, h, qb, ws, (char*)lds_raw) : 0.f;
                bool dead = false;
                if (lane < NTf - 4) { const float fj = FTp[(rowbase + 64 * lane + 63) * 8 + h]; dead = (Bq - fj + Gp) < -40.f; }
                const unsigned long long bm = __ballot(dead);
                int n0 = bm == ~0ull ? 64 : __builtin_ctzll(~bm); n0 = __builtin_amdgcn_readfirstlane(n0 & ~1);
                attn::attn_unit<false, 8>(xq, h, qb, ws, (char*)lds_raw, n0);
            }
            if (wave == 0) { unsigned cq = 256u; if (lane < 8) cq = __hip_atomic_load(ctl + CW_Q + 64 * lane, __ATOMIC_RELAXED, __HIP_MEMORY_SCOPE_AGENT);
                const unsigned long long mq = __ballot(cq < 256u); if (lane == 0) MISC[5] = (unsigned)mq; }
            __syncthreads();
            const unsigned mleft = (unsigned)__builtin_amdgcn_readfirstlane((int)MISC[5]) & 0xffu;
            __syncthreads();
            if (mleft == 0u) break;
            { const unsigned rot = ((mleft >> xg) | (mleft << (8 - xg))) & 0xffu; xq = (xg + __builtin_ctz(rot)) & 7; }
          }
        }
    }
    xcd_barrier(bar);

    REP(6)
    {
        g8::DenseSched S; S.init(O, ws + WS_WOUT, T, D, D, G, (int)blockIdx.x);
        g8::EpiBf16Out E{OP, D, 0, 0, 1.f};
        g8::gemm_phase<g8::EpiBf16Out, g8::DenseSched, true>(lds, D, S, E);
    }
    xcd_barrier(bar);

    {
        PH_IDS
        const float* gpost = (const float*)a.in[I_GAPOST]; const float* gpre = (const float*)a.in[I_GMPRE];
        const float* wr = (const float*)a.in[I_WR]; const float* br = (const float*)a.in[I_BR];
        LAS float* hT = (LAS float*)lds;
        LAS float* part = (LAS float*)(lds + 65536);
        LAS int* lcnt = (LAS int*)(lds + 131072); LAS int* lbase = lcnt + 32; LAS int* lpos = lcnt + 64; LAS int* le = lpos + 512; LAS int* lgt = le + 512;
        const int tt = lane & 15, g4 = lane >> 4;
        g8::bf16x8 Whi[4][2], Wlo[4][2];
#pragma unroll
        for (int ks = 0; ks < 4; ++ks)
#pragma unroll
            for (int eb = 0; eb < 2; ++eb)
#pragma unroll
                for (int j = 0; j < 8; ++j) { const float f = wr[(size_t)(wave * 128 + ks * 32 + 8 * g4 + j) * 32 + eb * 16 + tt]; const unsigned h = f2bf(f); const unsigned l = f2bf(f - __uint_as_float(h << 16));
                    Whi[ks][eb][j] = (short)h; Wlo[ks][eb][j] = (short)l; }
        const int myE = lane & 31, myR = lane >> 5; const float brE = br[myE];
        for (int ch = blockIdx.x; ch < T / 128; ch += G) {
            const int b = (ch * 128) / SEQ; const float* ada = ADA + b * 6144;
            LAS f32x4* cst = (LAS f32x4*)(lds + 81920);
            if (tid < 32) lcnt[tid] = 0;
            { int tq = threadIdx.x; asm volatile("" : "+v"(tq));
              if (tq < 256) { cst[tq] = ((const f32x4*)gpost)[tq] * ((const f32x4*)(ada + 2048))[tq]; cst[256 + tq] = ((const f32x4*)gpre)[tq] * (((const f32x4*)(ada + 4096))[tq] + 1.f); cst[512 + tq] = ((const f32x4*)(ada + 3072))[tq]; } }
            __syncthreads();
            f32x4 v[2][4], vn[2][4]; u32x2 p[2][4], pn[2][4];
#define P7_LOAD(P_, V_, tok) do { _Pragma("unroll") for (int r = 0; r < 2; ++r) _Pragma("unroll") for (int j = 0; j < 4; ++j) { \
                P_[r][j] = __builtin_nontemporal_load((const u32x2*)(OP + (size_t)((tok) + r) * D) + lane + 64 * j); V_[r][j] = __builtin_nontemporal_load((const f32x4*)(XIN + (size_t)((tok) + r) * D) + lane + 64 * j); } } while (0)
            P7_LOAD(pn, vn, ch * 128 + wave * 2);
            for (int ti = 0; ti < 8; ++ti) {
                const int lt0 = ti * 16 + wave * 2, t0 = ch * 128 + lt0;
#pragma unroll
                for (int r = 0; r < 2; ++r)
#pragma unroll
                    for (int j = 0; j < 4; ++j) { p[r][j] = pn[r][j]; v[r][j] = vn[r][j]; }
                __builtin_amdgcn_sched_barrier(0);
                if (ti < 7) { P7_LOAD(pn, vn, t0 + 16); }
                __builtin_amdgcn_sched_barrier(0);
                float rs[2];
#pragma unroll
                for (int r = 0; r < 2; ++r) { float s = 0.f;
#pragma unroll
                    for (int j = 0; j < 4; ++j) { const float a0 = bflo(p[r][j].x), a1 = bfhi(p[r][j].x), a2 = bflo(p[r][j].y), a3 = bfhi(p[r][j].y); s += a0 * a0 + a1 * a1 + a2 * a2 + a3 * a3; }
                    rs[r] = 1.f / sqrtf(wave_sum(s) * (1.f / D) + RMS_EPS); }
                float s2[2] = {0.f, 0.f};
#pragma unroll
                for (int j = 0; j < 4; ++j) { const f32x4 cA = cst[lane + 64 * j];
#pragma unroll
                    for (int r = 0; r < 2; ++r) { const f32x4 o4 = (f32x4){bflo(p[r][j].x), bfhi(p[r][j].x), bflo(p[r][j].y), bfhi(p[r][j].y)};
                        v[r][j] = v[r][j] + cA * (o4 * rs[r]); { u32x2 xb; xb.x = pk2(v[r][j].x, v[r][j].y); xb.y = pk2(v[r][j].z, v[r][j].w); ((u32x2*)((bf16*)(ws + WS_X1) + (size_t)(t0 + r) * D))[lane + 64 * j] = xb; }
                        s2[r] += v[r][j].x * v[r][j].x + v[r][j].y * v[r][j].y + v[r][j].z * v[r][j].z + v[r][j].w * v[r][j].w; } }
#pragma unroll
                for (int r = 0; r < 2; ++r) rs[r] = 1.f / sqrtf(wave_sum(s2[r]) * (1.f / D) + RMS_EPS);
#pragma unroll
                for (int j = 0; j < 4; ++j) { const f32x4 cB = cst[256 + lane + 64 * j], cH = cst[512 + lane + 64 * j];
#pragma unroll
                    for (int r = 0; r < 2; ++r) { v[r][j] = v[r][j] * rs[r] * cB + cH;
                        ((unsigned*)((unsigned char*)H + (size_t)(t0 + r) * D))[lane + 64 * j] = g8::pk4_fp8(v[r][j].x, v[r][j].y, v[r][j].z, v[r][j].w);
                        *(LAS f32x4*)(hT + (2 * wave + r) * 1024 + 4 * ((lane + 64 * j) ^ ((2 * wave + r) & 15))) = v[r][j]; } }
                __syncthreads();
                __builtin_amdgcn_sched_barrier(0);
                f32x4 dacc[2] = {{0.f, 0.f, 0.f, 0.f}, {0.f, 0.f, 0.f, 0.f}};
#pragma unroll
                for (int ks = 0; ks < 4; ++ks) { const int c0 = (wave * 128 + ks * 32 + 8 * g4) >> 2;
                    const f32x4 fa = *(const LAS f32x4*)(hT + tt * 1024 + 4 * (c0 ^ tt)), fb = *(const LAS f32x4*)(hT + tt * 1024 + 4 * ((c0 + 1) ^ tt));
                    g8::bf16x8 Bhi, Blo;
#pragma unroll
                    for (int j = 0; j < 8; ++j) { const float f = j < 4 ? fa[j & 3] : fb[j & 3]; const unsigned h = f2bf(f); const unsigned l = f2bf(f - __uint_as_float(h << 16)); Bhi[j] = (short)h; Blo[j] = (short)l; }
#pragma unroll
                    for (int eb = 0; eb < 2; ++eb) { dacc[eb] = __builtin_amdgcn_mfma_f32_16x16x32_bf16(Whi[ks][eb], Bhi, dacc[eb], 0, 0, 0);
                        dacc[eb] = __builtin_amdgcn_mfma_f32_16x16x32_bf16(Whi[ks][eb], Blo, dacc[eb], 0, 0, 0); dacc[eb] = __builtin_amdgcn_mfma_f32_16x16x32_bf16(Wlo[ks][eb], Bhi, dacc[eb], 0, 0, 0); } }
#pragma unroll
                for (int eb = 0; eb < 2; ++eb) *(LAS f32x4*)(part + (wave * 16 + tt) * 32 + 16 * eb + 4 * g4) = dacc[eb];
                __syncthreads();
                float lg = brE;
#pragma unroll
                for (int wv = 0; wv < 8; ++wv) lg += part[(wv * 16 + 2 * wave + myR) * 32 + myE];
                int te[2][4]; float tg[2][4];
                { float tv[2][4]; float cur = lg;
#define P7_DPPF(x, ctrl) __int_as_float(__builtin_amdgcn_update_dpp(0, __float_as_int(x), (ctrl), 0xF, 0xF, true))
#pragma unroll
                  for (int i = 0; i < 4; ++i) { float m = cur;
                      m = fmaxf(m, P7_DPPF(m, 0xB1)); m = fmaxf(m, P7_DPPF(m, 0x4E)); m = fmaxf(m, P7_DPPF(m, 0x141)); m = fmaxf(m, P7_DPPF(m, 0x140));
                      m = fmaxf(m, __int_as_float(__builtin_amdgcn_ds_swizzle(__float_as_int(m), 0x401F)));
                      const unsigned long long mk = __ballot(cur == m); const int l0 = __builtin_ctz((unsigned)mk), l1 = __builtin_ctz((unsigned)(mk >> 32));
                      te[0][i] = l0; te[1][i] = l1; tv[0][i] = __uint_as_float(__builtin_amdgcn_readlane(__float_as_uint(m), 0)); tv[1][i] = __uint_as_float(__builtin_amdgcn_readlane(__float_as_uint(m), 32));
                      if (lane == l0 || lane == 32 + l1) cur = -INFINITY; }
#undef P7_DPPF
#pragma unroll
                  for (int r = 0; r < 2; ++r) { const float e1 = expf(tv[r][1] - tv[r][0]), e2 = expf(tv[r][2] - tv[r][0]), e3 = expf(tv[r][3] - tv[r][0]); const float inv = 1.f / (1.f + e1 + e2 + e3);
                      tg[r][0] = inv; tg[r][1] = e1 * inv; tg[r][2] = e2 * inv; tg[r][3] = e3 * inv; } }
                if (lane < 8) { const int r = lane >> 2, i = lane & 3;
                    const int me = r == 0 ? (i == 0 ? te[0][0] : i == 1 ? te[0][1] : i == 2 ? te[0][2] : te[0][3]) : (i == 0 ? te[1][0] : i == 1 ? te[1][1] : i == 2 ? te[1][2] : te[1][3]);
                    const float mg = r == 0 ? (i == 0 ? tg[0][0] : i == 1 ? tg[0][1] : i == 2 ? tg[0][2] : tg[0][3]) : (i == 0 ? tg[1][0] : i == 1 ? tg[1][1] : i == 2 ? tg[1][2] : tg[1][3]);
                    TOPG[(t0 + r) * 4 + i] = mg;
                    const int pp = __hip_atomic_fetch_add(lcnt + me, 1, __ATOMIC_RELAXED, __HIP_MEMORY_SCOPE_WORKGROUP);
                    lpos[(lt0 + r) * 4 + i] = pp; le[(lt0 + r) * 4 + i] = me; lgt[(lt0 + r) * 4 + i] = (int)__float_as_uint(mg); }
            }
#undef P7_LOAD
            __syncthreads();
            { int t3 = threadIdx.x; asm volatile("" : "+v"(t3));
              if (t3 < 32) lbase[t3] = (int)__hip_atomic_fetch_add(ctl + CW_CNT + 64 * t3, (unsigned)lcnt[t3], __ATOMIC_RELAXED, __HIP_MEMORY_SCOPE_AGENT);
              __syncthreads();
              { const int e = le[t3]; const int pos = lbase[e] + lpos[t3]; u32x2 rec; rec.x = (unsigned)(ch * 512 + t3); rec.y = (unsigned)lgt[t3]; ((u32x2*)LIST)[(size_t)e * T + pos] = rec;
                TOPE[ch * 512 + t3] = (e << 16) | pos; } }
            __syncthreads();
        }
    }
    xcd_barrier(bar);

#define MOE_TABLES PH_IDS int cntE = 0; if (lane < 32) cntE = (int)__hip_atomic_load(ctl + CW_CNT + 64 * lane, __ATOMIC_RELAXED, __HIP_MEMORY_SCOPE_AGENT); \
        int pend256, ebaseE, tot256; { const int n2 = (cntE + 255) >> 8; int i1 = n2; \
          _Pragma("unroll") for (int o = 1; o < 32; o <<= 1) { const int u1 = __shfl_up(i1, o); if (lane >= o) i1 += u1; } \
          pend256 = i1; ebaseE = (i1 - n2) * 256; tot256 = __shfl(i1, 31); }
    REP(8)
    {
        MOE_TABLES
        g8::MoeSched<true> S{cntE, pend256, ebaseE, tot256, 8, G, (int)blockIdx.x, D / 2, lane, (const char*)H, (const char*)(ws + WS_WGU), (size_t)2048 * 1024, LIST};
        g8::EpiGU8 E{(unsigned char*)ACT, (const float*)a.in[I_BGU], 1.f / W8_SCALE, (const LAS float*)(lds + 131072)};
        if (G == 256) { const int xs = (int)blockIdx.x & 7, js = (int)blockIdx.x >> 3; dephase(xs < 4 ? (xs * 32 + js) : 128 + ((xs - 4) * 32 + js) * 5 / 2); }
        g8::gemm_phase<g8::EpiGU8, g8::MoeSched<true>, true, true>(lds, D / 2, S, E);
    }
    xcd_barrier(bar);

    REP(9)
    {
        MOE_TABLES
        g8::MoeSched<false> S{cntE, pend256, ebaseE, tot256, 4, G, (int)blockIdx.x, D / 2, lane, (const char*)ACT, (const char*)(ws + WS_WDN), (size_t)1024 * 1024, LIST};
        g8::EpiDown E{(unsigned char*)Y, (const float*)a.in[I_BDN], 1.f / W8_SCALE, (const LAS float*)(lds + 131072)};
        if (G == 256) { const int xs = (int)blockIdx.x & 7, js = (int)blockIdx.x >> 3; dephase(xs < 2 ? (xs * 32 + js) : 64 + ((xs - 2) * 32 + js) * 2); }
        g8::gemm_phase<g8::EpiDown, g8::MoeSched<false>, true, true>(lds, D / 2, S, E);
    }
    xcd_barrier(bar);
#undef MOE_TABLES

    for (int rep10_ = 0; rep10_ < ((PROBE_PHASE) == 10 ? 2 : 1); ++rep10_)
    {
        PH_IDS
        int ebaseE;
        { int cntE = 0; if (lane < 32) cntE = (int)__hip_atomic_load(ctl + CW_CNT + 64 * lane, __ATOMIC_RELAXED, __HIP_MEMORY_SCOPE_AGENT);
          const int n2 = (cntE + 255) >> 8; int i1 = n2;
#pragma unroll
          for (int o = 1; o < 32; o <<= 1) { const int u1 = __shfl_up(i1, o); if (lane >= o) i1 += u1; }
          ebaseE = (i1 - n2) * 256; }
        const float* gpost = (const float*)a.in[I_GMPOST];
        for (int ch = gw; ch < T / 16; ch += NGW) {
            const int t0 = ch * 16, b = t0 / SEQ; const float* gtm = ADA + b * 6144 + 5120;
            f32x4 gg[4];
#pragma unroll
            for (int j = 0; j < 4; ++j) gg[j] = ((const f32x4*)gpost)[lane + 64 * j] * ((const f32x4*)gtm)[lane + 64 * j];
            unsigned y[2][4][4], yn[2][4][4]; u32x2 xo[2][4], xn[2][4]; float gq[2][4], gqn[2][4];
#define P10_LOAD(Y_, X_, G_, tok) do { _Pragma("unroll") for (int r = 0; r < 2; ++r) { _Pragma("unroll") for (int q = 0; q < 4; ++q) { \
                const int ip_ = __builtin_amdgcn_readfirstlane(TOPE[((tok) + r) * 4 + q]); const int row_ = __builtin_amdgcn_readlane(ebaseE, ip_ >> 16) + (ip_ & 0xffff); G_[r][q] = TOPG[((tok) + r) * 4 + q]; \
                _Pragma("unroll") for (int j = 0; j < 4; ++j) Y_[r][q][j] = __builtin_nontemporal_load((const unsigned*)((const unsigned char*)Y + (size_t)row_ * D) + lane + 64 * j); } \
                _Pragma("unroll") for (int j = 0; j < 4; ++j) X_[r][j] = __builtin_nontemporal_load((const u32x2*)((const bf16*)(ws + WS_X1) + (size_t)((tok) + r) * D) + lane + 64 * j); } } while (0)
            P10_LOAD(yn, xn, gqn, t0);
            for (int i = 0; i < 16; i += 2) {
#pragma unroll
                for (int r = 0; r < 2; ++r) {
#pragma unroll
                    for (int q = 0; q < 4; ++q)
#pragma unroll
                        for (int j = 0; j < 4; ++j) y[r][q][j] = yn[r][q][j];
#pragma unroll
                    for (int j = 0; j < 4; ++j) xo[r][j] = xn[r][j];
#pragma unroll
                    for (int q = 0; q < 4; ++q) gq[r][q] = gqn[r][q]; }
                if (i < 14) { P10_LOAD(yn, xn, gqn, t0 + i + 2); }
                __builtin_amdgcn_sched_barrier(0);
#pragma unroll
                for (int r = 0; r < 2; ++r) { f32x4 v[4]; float s = 0.f;
#pragma unroll
                    for (int j = 0; j < 4; ++j) { f32x4 acc = {0.f, 0.f, 0.f, 0.f};
#pragma unroll
                        for (int q = 0; q < 4; ++q) { const int w = (int)y[r][q][j]; acc += (f32x4){__builtin_amdgcn_cvt_f32_fp8(w, 0), __builtin_amdgcn_cvt_f32_fp8(w, 1), __builtin_amdgcn_cvt_f32_fp8(w, 2), __builtin_amdgcn_cvt_f32_fp8(w, 3)} * gq[r][q]; }
                        acc = acc * (1.f / Y8_SCALE); v[j] = acc; s += acc.x * acc.x + acc.y * acc.y + acc.z * acc.z + acc.w * acc.w; }
                    const float rstd = 1.f / sqrtf(wave_sum(s) * (1.f / D) + RMS_EPS);
#pragma unroll
                    for (int j = 0; j < 4; ++j) __builtin_nontemporal_store((f32x4){bflo(xo[r][j].x), bfhi(xo[r][j].x), bflo(xo[r][j].y), bfhi(xo[r][j].y)} + gg[j] * (v[j] * rstd), (f32x4*)(((PROBE_PHASE) == 10 && rep10_ == 0 ? (float*)(ws + WS_H) : a.out) + (size_t)(t0 + i + r) * D) + lane + 64 * j); }
            }
#undef P10_LOAD
        }
    }
}

#undef XIN
#undef ADA
#undef COS
#undef SIN
#undef LF
#undef FT
#undef KB
#undef KR
#undef TOPE
#undef TOPG
#undef LIST
#undef H
#undef PROJ
#undef CQN
#undef CKVN
#undef QM
#undef KV
#undef O
#undef OP
#undef ACT
#undef Y
extern "C" void kernel_launch(void* const* d_in, const int* in_sizes, int n_in, void* d_out, int out_size, void* d_ws, size_t ws_size, hipStream_t stream) {
    static int grid = 0;
    if (grid == 0) {
        if (n_in != 22 || out_size != T * D || ws_size < WS_END) { fprintf(stderr, "kernel_launch: unexpected shapes (n_in %d out %d ws %zu)\n", n_in, out_size, ws_size); grid = -1; return; }
        int dev = 0, cus = 0, per_cu = 0;
        if (hipGetDevice(&dev) != hipSuccess || hipDeviceGetAttribute(&cus, hipDeviceAttributeMultiprocessorCount, dev) != hipSuccess) { grid = -1; return; }
        if (hipFuncSetAttribute((const void*)fwd, hipFuncAttributeMaxDynamicSharedMemorySize, LDS_BYTES) != hipSuccess) { fprintf(stderr, "kernel_launch: hipFuncSetAttribute failed\n"); grid = -1; return; }
        if (hipOccupancyMaxActiveBlocksPerMultiprocessor(&per_cu, (const void*)fwd, 512, LDS_BYTES) != hipSuccess || per_cu < 1) fprintf(stderr, "kernel_launch: occupancy query says %d\n", per_cu);
        (void)hipGetLastError();
        grid = cus;
    }
    if (grid < 0) return;
    (void)hipMemsetAsync((char*)d_ws + WS_CTL, 0, CTL_ZERO_BYTES, stream);
    Args a{};
    for (int i = 0; i < 22; ++i) a.in[i] = d_in[i];
    a.out = (float*)d_out; a.ws = (unsigned char*)d_ws;
    hipLaunchKernelGGL(fwd, dim3(grid), dim3(512), LDS_BYTES, stream, a);
}
```

```cpp
#include <hip/hip_runtime.h>
#include <cstdio>
#include <cstdint>

#define GAS __attribute__((address_space(1)))
#define LAS __attribute__((address_space(3)))
typedef unsigned short bf16;
typedef float f32x4 __attribute__((ext_vector_type(4)));
typedef unsigned u32x4 __attribute__((ext_vector_type(4)));
typedef unsigned u32x2 __attribute__((ext_vector_type(2)));
typedef float f32x2v __attribute__((ext_vector_type(2)));

#ifndef PROBE_PHASE
#define PROBE_PHASE -1
#endif
#define REP(k) for (int rep_ = 0; rep_ < ((PROBE_PHASE) == (k) ? 2 : 1); ++rep_)
constexpr int NB = 8, SEQ = 4096, D = 1024, T = NB * SEQ;
constexpr int NE = 32, NA = T * 4;
constexpr int INW = 1960, PW = 2048;
constexpr int QW = 768, KVW = 1024;
constexpr float RMS_EPS = 1e-6f;
constexpr float LOG2E = 1.4426950408889634f;
constexpr float Y8_SCALE = 8.f;
constexpr float W8_SCALE = 64.f;
constexpr float C2F = 0.125f * LOG2E;
constexpr float C2M = 0.10206207261596577f * LOG2E;

constexpr size_t MiB = 1u << 20;
constexpr size_t WS_CTL = 0, CTL_ZERO_BYTES = 1 * MiB;
constexpr size_t WS_CS = 512 * 1024;
constexpr size_t WS_ADA = 1 * MiB;
constexpr size_t WS_COS = 2 * MiB, WS_SIN = 4 * MiB;
constexpr size_t WS_LF = 6 * MiB, WS_FT = 7 * MiB;
constexpr size_t WS_KB = 8 * MiB;
constexpr size_t WS_KR = 12 * MiB;
constexpr size_t WS_TOPE = 14 * MiB, WS_TOPG = 14 * MiB + 512 * 1024;
constexpr size_t WS_LIST = 812 * MiB;
constexpr size_t WS_WIN = 20 * MiB, WS_WUQ = 24 * MiB, WS_WUKV = 25 * MiB, WS_WOUT = 26 * MiB, WS_WGU = 28 * MiB, WS_WDN = 156 * MiB;
constexpr size_t WS_H = 220 * MiB;
constexpr size_t WS_PROJ = 284 * MiB;
constexpr size_t WS_CQN = 412 * MiB, WS_CKVN = 428 * MiB, WS_QM = 436 * MiB, WS_KV = 484 * MiB, WS_O = 548 * MiB, WS_OP = 612 * MiB;
constexpr size_t WS_ACT = 284 * MiB;
constexpr size_t WS_X1 = 700 * MiB;
constexpr size_t WS_Y = 556 * MiB;
constexpr size_t WS_END = 820 * MiB;
constexpr int CW_CNT = 64;
constexpr int CW_NRM = 2560;
constexpr int CW_Q = 3072;
constexpr int CW_BAR = 4096;

constexpr int LDS_BYTES = 147456;
constexpr int MISC_OFF = LDS_BYTES - 64;

__device__ __forceinline__ float bflo(unsigned u) { return __uint_as_float(u << 16); }
__device__ __forceinline__ float bfhi(unsigned u) { return __uint_as_float(u & 0xffff0000u); }
__device__ __forceinline__ float bf2f(bf16 b) { return __uint_as_float(((unsigned)b) << 16); }
__device__ __forceinline__ unsigned f2bf(float f) { unsigned u = __float_as_uint(f); return (u + 0x7fffu + ((u >> 16) & 1u)) >> 16; }
__device__ __forceinline__ unsigned pk2(float lo, float hi) { return f2bf(lo) | (f2bf(hi) << 16); }
__device__ __forceinline__ float wave_sum(float v) {
#pragma unroll
    for (int o = 1; o < 64; o <<= 1) v += __shfl_xor(v, o);
    return v;
}
__device__ __forceinline__ float wave_max(float v) {
#pragma unroll
    for (int o = 1; o < 64; o <<= 1) v = fmaxf(v, __shfl_xor(v, o));
    return v;
}
__host__ __device__ inline int inproj_src(int cp) {
    if (cp < 416) return cp;
    if (cp < 424) return 1952 + (cp - 416);
    if (cp < 512) return -1;
    if (cp < 1024) return 416 + (cp - 512);
    if (cp < 1536) return 928 + (cp - 1024);
    return 1440 + (cp - 1536);
}

#define XB_TMO      128
#define XB_XCNT(j)  (256  + 64 * (j))
#define XB_XSUB(j)  (1280 + 64 * (j))
#define XB_XGEN(j)  (2304 + 64 * (j))
#define XB_TOP      3328
#define XB_TOPGEN   3392
#define XCD_BAR_WORDS 3456
#define XB_SPIN_CAP (1u << 22)
__device__ __forceinline__ unsigned xb_ld(unsigned* p)              { return __hip_atomic_load(p, __ATOMIC_RELAXED, __HIP_MEMORY_SCOPE_AGENT); }
__device__ __forceinline__ unsigned xb_add(unsigned* p, unsigned v) { return __hip_atomic_fetch_add(p, v, __ATOMIC_RELAXED, __HIP_MEMORY_SCOPE_AGENT); }
__device__ __forceinline__ unsigned xb_xcc_id() { return (unsigned)__builtin_amdgcn_s_getreg((3 << 11) | 20) & 0xFu; }
#define XB_SPIN(cond, bar) do { unsigned _sp = 0; while (cond) { __builtin_amdgcn_s_sleep(1); \
    if ((++_sp & 255u) == 0u) { if (xb_ld(&(bar)[XB_TMO])) break; if (_sp > XB_SPIN_CAP) { atomicAdd(&(bar)[XB_TMO], 1u); break; } } } } while (0)
struct XcdBarrier { unsigned* bar; unsigned x; volatile LAS unsigned* st; };
__device__ __forceinline__ XcdBarrier xcd_barrier_post(unsigned* bar, volatile LAS unsigned* st) {
    XcdBarrier b; b.bar = bar; b.x = xb_xcc_id(); b.st = st;
    if (threadIdx.x == 0) (void)xb_add(&bar[XB_XCNT(b.x)], 1u);
    return b;
}
__device__ __forceinline__ void xcd_barrier_complete(unsigned* bar, unsigned x, unsigned& nloc, unsigned& nx) {
    const unsigned G = gridDim.x * gridDim.y * gridDim.z;
    unsigned sum, cnt, mine, sp = 0u;
    for (;;) {
        sum = 0u; cnt = 0u; mine = 0u;
#pragma unroll
        for (unsigned j = 0; j < 16; ++j) { const unsigned c = xb_ld(&bar[XB_XCNT(j)]); sum += c; cnt += (c > 0u) ? 1u : 0u; mine = (j == x) ? c : mine; }
        if (sum == G) break;
        __builtin_amdgcn_s_sleep(1);
        if ((++sp & 255u) == 0u) { if (xb_ld(&bar[XB_TMO])) break; if (sp > XB_SPIN_CAP) { atomicAdd(&bar[XB_TMO], 1u); break; } }
    }
    nloc = mine > 0u ? mine : 1u; nx = cnt > 0u ? cnt : 1u;
}
__device__ __forceinline__ void xcd_barrier(const XcdBarrier& b) {
    asm volatile("s_waitcnt vmcnt(0)" ::: "memory");
    __syncthreads();
    if (threadIdx.x == 0) {
        unsigned* bar = b.bar;
        __builtin_amdgcn_s_waitcnt(0);
        unsigned nloc = b.st[0], nx = b.st[1];
        if (nloc == 0u) { xcd_barrier_complete(bar, b.x, nloc, nx); b.st[0] = nloc; b.st[1] = nx; }
        const unsigned old = xb_add(&bar[XB_XSUB(b.x)], 1u);
        const unsigned gen = old / nloc;
        if (old + 1u == (gen + 1u) * nloc) {
            __builtin_amdgcn_fence(__ATOMIC_RELEASE, "agent");
            asm volatile("s_waitcnt vmcnt(0)" ::: "memory");
            const unsigned og = xb_add(&bar[XB_TOP], 1u);
            const unsigned tg = og / nx;
            if (og + 1u == (tg + 1u) * nx) xb_add(&bar[XB_TOPGEN], 1u);
            else XB_SPIN(xb_ld(&bar[XB_TOPGEN]) == tg, bar);
            __builtin_amdgcn_fence(__ATOMIC_ACQUIRE, "agent");
            xb_add(&bar[XB_XGEN(b.x)], 1u);
            asm volatile("s_waitcnt vmcnt(0)" ::: "memory");
        } else {
            XB_SPIN(xb_ld(&bar[XB_XGEN(b.x)]) == gen, bar);
            __builtin_amdgcn_fence(__ATOMIC_ACQUIRE, "agent");
            asm volatile("s_waitcnt vmcnt(0)" ::: "memory");
        }
    }
    __syncthreads();
}

struct Args { const void* in[22]; float* out; unsigned char* ws; };
enum { I_X = 0, I_C, I_POS, I_WADA, I_BADA, I_GAPRE, I_GAPOST, I_WIN, I_GQ, I_WUQ, I_GKV, I_WUKV, I_BF, I_WOUT, I_GMPRE, I_GMPOST, I_WR, I_BR, I_WGU, I_BGU, I_WDN, I_BDN };

namespace g8 {
typedef short bf16x8 __attribute__((ext_vector_type(8)));
constexpr int BM = 256, BK = 64, HALF = 128, HTB = HALF * BK * 2, STAGE_BYTES = 8 * HTB;
__host__ __device__ __forceinline__ int lds_byte(int r, int c) { const int st = (r >> 4) * 2 + (c >> 5), rr = r & 15, cc = c & 31, ob = rr * 64 + cc * 2; return st * 1024 + (ob ^ (((ob >> 9) & 1) << 5)); }
__host__ __device__ __forceinline__ void stage_rc(int b, int& R, int& C) { const int st = b / 1024, sb = b % 1024, swz = sb ^ (((sb >> 9) & 1) << 5); R = (st >> 1) * 16 + swz / 64; C = (st & 1) * 32 + (swz % 64) / 2; }
__host__ __device__ __forceinline__ int perm32(int rho) { const int n = rho >> 4, i = rho & 15; return 8 * (i >> 2) + 4 * n + (i & 3); }
__device__ __forceinline__ unsigned cvt_pk_bf16(float lo, float hi) { unsigned r; asm volatile("v_cvt_pk_bf16_f32 %0, %1, %2" : "=v"(r) : "v"(lo), "v"(hi)); return r; }

template <int OFF> __device__ __forceinline__ void glds16s(const char* sbase, unsigned voff, unsigned lds_w) {
    unsigned keep;
    asm volatile("s_mov_b32 %0, m0\n\ts_add_i32 m0, %3, %4\n\ts_nop 2\n\tglobal_load_lds_dwordx4 %1, %2\n\ts_mov_b32 m0, %0" : "=&s"(keep) : "v"(voff), "s"(sbase), "s"(lds_w), "n"(OFF) : "memory", "scc");
}
__device__ __forceinline__ const char* uni_ptr(const char* p) { const unsigned lo = __builtin_amdgcn_readfirstlane((unsigned)(uintptr_t)p), hi = __builtin_amdgcn_readfirstlane((unsigned)((uintptr_t)p >> 32)); return (const char*)(((uintptr_t)hi << 32) | (uintptr_t)lo); }
__device__ __forceinline__ void glds4s(const char* sbase, unsigned voff, unsigned lds_dst) {
    unsigned keep;
    asm volatile("s_mov_b32 %0, m0\n\ts_mov_b32 m0, %3\n\ts_nop 2\n\tglobal_load_lds_dword %1, %2\n\ts_mov_b32 m0, %0" : "=&s"(keep) : "v"(voff), "s"(sbase), "s"(lds_dst) : "memory");
}
struct Unit { const char* A; const char* B; int pm, pn, e, nv, rb, bs; };

typedef int i32x4v __attribute__((ext_vector_type(4)));
typedef int i32x8v __attribute__((ext_vector_type(8)));
__device__ __forceinline__ i32x8v cat8(bf16x8 lo, bf16x8 hi) { const i32x4v a = __builtin_bit_cast(i32x4v, lo), b = __builtin_bit_cast(i32x4v, hi); return __builtin_shufflevector(a, b, 0, 1, 2, 3, 4, 5, 6, 7); }
template <class Epi, class Sched, bool ALIGN_EPI, bool F8 = false>
__device__ __forceinline__ void gemm_phase(LAS unsigned char* lds, const int K, const Sched& S, const Epi& E) {
    int tid = threadIdx.x; asm volatile("" : "+v"(tid));
    const int wid = __builtin_amdgcn_readfirstlane(tid >> 6), lane = tid & 63, wr = wid >> 2, wc = wid & 3, fr = lane & 15, fq = lane >> 4;
    const int nt = K / BK;
    unsigned voffB[2];
#pragma unroll
    for (int i = 0; i < 2; ++i) { int R, C; stage_rc(tid * 16 + i * 8192, R, C); const int Rb = Epi::PERM ? ((R & ~31) + perm32(R & 31)) : R; voffB[i] = (unsigned)(Rb * K + C) * 2u; }
    const size_t kstep = (size_t)(BK * 2);
    const size_t hstep = (size_t)HALF * K * 2;
    const unsigned ldsW = (unsigned)__builtin_amdgcn_readfirstlane((unsigned)(uintptr_t)lds + (unsigned)wid * 1024u);
    const int aoff = lds_byte(wr * 64 + fr, fq * 8), boff = lds_byte(wc * 32 + fr, fq * 8);
#define G8_SA(b, h) (((b) * 2 + (h)) * HTB)
#define G8_SB(b, h) ((4 + (b) * 2 + (h)) * HTB)
#define G8_STAGE(bufoff, gbase, voff) do { glds16s<(bufoff)>((const char*)(gbase), (voff)[0], ldsW); glds16s<(bufoff) + 8192>((const char*)(gbase), (voff)[1], ldsW); } while (0)
#define G8_LD8(p) __builtin_shufflevector(*(const LAS i32x4v*)(p), *(const LAS i32x4v*)((p) + 1024), 0, 1, 2, 3, 4, 5, 6, 7)
#define G8_LDA(dst, b, h) do { _Pragma("unroll") for (int m = 0; m < 4; ++m) { if constexpr (F8) dst##8[m] = G8_LD8(lds + G8_SA(b, h) + aoff + m * 2048); \
        else { _Pragma("unroll") for (int k = 0; k < 2; ++k) dst[m][k] = *(const LAS bf16x8*)(lds + G8_SA(b, h) + aoff + m * 2048 + k * 1024); } } } while (0)
#define G8_LDB(dst, b, h) do { _Pragma("unroll") for (int n = 0; n < 2; ++n) { if constexpr (F8) dst##8[n] = G8_LD8(lds + G8_SB(b, h) + boff + n * 2048); \
        else { _Pragma("unroll") for (int k = 0; k < 2; ++k) dst[n][k] = *(const LAS bf16x8*)(lds + G8_SB(b, h) + boff + n * 2048 + k * 1024); } } } while (0)
#define G8_MMA(ai, bj, At, Bt) do { __builtin_amdgcn_s_setprio(1); _Pragma("unroll") for (int m = 0; m < 4; ++m) _Pragma("unroll") for (int n = 0; n < 2; ++n) { \
        if constexpr (F8) asm volatile("v_mfma_f32_16x16x128_f8f6f4 %0, %1, %2, %0" : "+v"(acc[ai][bj][m][n]) : "v"(Bt##8[n]), "v"(At##8[m]));   \
        else { _Pragma("unroll") for (int k = 0; k < 2; ++k) acc[ai][bj][m][n] = __builtin_amdgcn_mfma_f32_16x16x32_bf16(Bt[n][k], At[m][k], acc[ai][bj][m][n], 0, 0, 0); } } \
        __builtin_amdgcn_s_setprio(0); } while (0)
#define G8_WAIT_V(n) asm volatile("s_waitcnt vmcnt(" #n ")" ::: "memory")
#define G8_WAIT_L(n) asm volatile("s_waitcnt lgkmcnt(" #n ")" ::: "memory")
#define G8_BAR __builtin_amdgcn_s_barrier()
#define G8_SCHED __builtin_amdgcn_sched_barrier(0)
    Unit cur, nxt; int ui = 0;
    if (!S.next(0, cur)) return;
    cur.bs = 0;
    const unsigned ldsBias = (unsigned)__builtin_amdgcn_readfirstlane((unsigned)(uintptr_t)lds + 131072u + (unsigned)wid * 256u);
    f32x4 acc[2][2][4][2];
#pragma unroll
    for (int a = 0; a < 2; ++a)
#pragma unroll
        for (int b = 0; b < 2; ++b)
#pragma unroll
            for (int m = 0; m < 4; ++m)
#pragma unroll
                for (int n = 0; n < 2; ++n) { acc[a][b][m][n] = (f32x4){0.f, 0.f, 0.f, 0.f}; asm volatile("" : "+v"(acc[a][b][m][n])); }
    bf16x8 At[4][2], B0[2][2], B1[2][2]; i32x8v At8[4], B08[2], B18[2];
    unsigned cOff[2][2], nOff[2][2];
    S.aoffs(cur, tid, cOff);
    const char* cA = uni_ptr(cur.A); const char* cB = uni_ptr(cur.B);
#define G8_AH(base, h) (Sched::GATHER ? (base) : (base) + (h) * hstep)
#define G8_AO(off, h) (off)[Sched::GATHER ? (h) : 0]
    G8_STAGE(G8_SB(0, 0), cB, voffB); G8_STAGE(G8_SB(0, 1), cB + hstep, voffB); G8_STAGE(G8_SA(0, 0), G8_AH(cA, 0), G8_AO(cOff, 0)); G8_STAGE(G8_SA(0, 1), G8_AH(cA, 1), G8_AO(cOff, 1));
    if (wr == 1) G8_BAR;
    G8_WAIT_V(2); G8_BAR;
    G8_STAGE(G8_SB(1, 0), cB + kstep, voffB); G8_STAGE(G8_SA(1, 0), G8_AH(cA + kstep, 0), G8_AO(cOff, 0)); G8_STAGE(G8_SB(1, 1), cB + hstep + kstep, voffB);
    G8_WAIT_V(6); G8_BAR;
    for (;;) {
        const bool has_next = S.next(ui + 1, nxt);
        if constexpr (Epi::BIAS_LDS) { if (wid < 4) glds4s(uni_ptr((const char*)E.bias_src(cur, wid)), (unsigned)lane * 4u, ldsBias + (unsigned)cur.bs * 1024u); }
        if constexpr (Sched::GATHER) {
            if (has_next) S.aoffs(nxt, tid, nOff);
            else {
#pragma unroll
                for (int h = 0; h < 2; ++h)
#pragma unroll
                    for (int i = 0; i < 2; ++i) nOff[h][i] = cOff[h][i];
            }
        }
        const char* nA = uni_ptr(has_next ? nxt.A : cA); const char* nB = uni_ptr(has_next ? nxt.B : cB);
        for (int t = 0; t < nt; t += 2) {
            const bool last = (t == nt - 2);
            const char* a1 = cA + (size_t)(t + 1) * kstep;
            const char* a2 = last ? nA : cA + (size_t)(t + 2) * kstep; const char* b2 = last ? nB : cB + (size_t)(t + 2) * kstep;
            const char* a3 = a2 + kstep; const char* b3 = b2 + kstep;
            unsigned o2[2][2];
#pragma unroll
            for (int h = 0; h < 2; ++h)
#pragma unroll
                for (int i = 0; i < 2; ++i) o2[h][i] = (Sched::GATHER && last) ? nOff[h][i] : cOff[h][i];
            G8_LDB(B0, 0, 0); G8_LDB(B1, 0, 1); G8_SCHED; G8_LDA(At, 0, 0); G8_STAGE(G8_SA(1, 1), G8_AH(a1, 1), G8_AO(cOff, 1));
            G8_WAIT_V(8); G8_WAIT_L(0); G8_BAR; G8_MMA(0, 0, At, B0); G8_MMA(0, 1, At, B1); G8_BAR; G8_SCHED;
            G8_LDA(At, 0, 1); G8_STAGE(G8_SB(0, 0), b2, voffB); G8_STAGE(G8_SB(0, 1), b2 + hstep, voffB); G8_STAGE(G8_SA(0, 0), G8_AH(a2, 0), G8_AO(o2, 0));
            G8_WAIT_V(8); G8_WAIT_L(0); G8_BAR; G8_MMA(1, 0, At, B0); G8_MMA(1, 1, At, B1); G8_BAR; G8_SCHED;
            G8_LDB(B0, 1, 0); G8_LDB(B1, 1, 1); G8_SCHED; G8_LDA(At, 1, 0); G8_STAGE(G8_SA(0, 1), G8_AH(a2, 1), G8_AO(o2, 1));
            G8_WAIT_V(8); G8_WAIT_L(0); G8_BAR; G8_MMA(0, 0, At, B0); G8_MMA(0, 1, At, B1); G8_BAR; G8_SCHED;
            G8_LDA(At, 1, 1); G8_STAGE(G8_SB(1, 0), b3, voffB); G8_STAGE(G8_SB(1, 1), b3 + hstep, voffB); G8_STAGE(G8_SA(1, 0), G8_AH(a3, 0), G8_AO(o2, 0));
            G8_WAIT_V(8); G8_WAIT_L(0); G8_BAR; G8_MMA(1, 0, At, B0); G8_MMA(1, 1, At, B1); G8_BAR; G8_SCHED;
        }
        if constexpr (ALIGN_EPI) { if (wr == 0) G8_BAR; }
        if constexpr (F8) asm volatile("s_nop 15\n\ts_nop 7" ::: "memory");
        { int t2 = threadIdx.x; asm volatile("" : "+v"(t2)); E(acc, cur, wr, wc, t2 & 15, (t2 & 63) >> 4); }
        if (!has_next) break;
#pragma unroll
        for (int a = 0; a < 2; ++a)
#pragma unroll
            for (int b = 0; b < 2; ++b)
#pragma unroll
                for (int m = 0; m < 4; ++m)
#pragma unroll
                    for (int n = 0; n < 2; ++n) { acc[a][b][m][n] = (f32x4){0.f, 0.f, 0.f, 0.f}; asm volatile("" : "+v"(acc[a][b][m][n])); }
        cur = nxt; cA = nA; cB = nB; ++ui; cur.bs = ui & 1;
        if constexpr (Sched::GATHER) {
#pragma unroll
            for (int h = 0; h < 2; ++h)
#pragma unroll
                for (int i = 0; i < 2; ++i) cOff[h][i] = nOff[h][i];
        }
        if constexpr (ALIGN_EPI) { if (wr == 1) G8_BAR; }
    }
    G8_WAIT_V(0);
    if constexpr (!ALIGN_EPI) { if (wr == 0) G8_BAR; }
    G8_BAR;
#undef G8_SA
#undef G8_AH
#undef G8_AO
#undef G8_SB
#undef G8_STAGE
#undef G8_LDA
#undef G8_LD8
#undef G8_LDB
#undef G8_MMA
#undef G8_WAIT_V
#undef G8_WAIT_L
#undef G8_BAR
#undef G8_SCHED
}

constexpr int NXCD = 8, WGM = 8;
struct DenseSched {
    const char* A; const char* Bt; int K, nM, nN, nwg, G, c; bool spread = false;
    __device__ __forceinline__ void init(const void* A_, const void* Bt_, int M, int N, int K_, int G_, int c_) { A = (const char*)A_; Bt = (const char*)Bt_; K = K_; nM = M / BM; nN = N / BM; nwg = nM * nN; G = G_; c = c_; }
    __device__ __forceinline__ bool next(int i, Unit& u) const {
        if (spread && G == 256 && nM == 128 && nN == 8) {
            if (i >= 4) return false;
            const int x = c & 7, j = c >> 3;
            u.pm = 16 * x + 4 * i + (j >> 3); u.pn = ((j & 7) + 2 * i) & 7; u.e = 0; u.nv = 256; u.rb = u.pm * 256;
            u.A = A + (size_t)u.pm * 256 * K * 2; u.B = Bt + (size_t)u.pn * 256 * K * 2; return true;
        }
        const long L = (long)i * G + c; if (L >= nwg) return false;
        int wgid = (int)L; { const int q = nwg / NXCD, r = nwg % NXCD, xcd = wgid % NXCD, off = wgid / NXCD; wgid = (xcd < r ? xcd * (q + 1) : r * (q + 1) + (xcd - r) * q) + off; }
        const int nig = WGM * nN, gid = wgid / nig, fm = gid * WGM, gsz = (nM - fm) < WGM ? (nM - fm) : WGM;
        u.pm = fm + ((wgid % nig) % gsz); u.pn = (wgid % nig) / gsz; u.e = 0; u.nv = 256; u.rb = u.pm * 256;
        u.A = A + (size_t)u.pm * 256 * K * 2; u.B = Bt + (size_t)u.pn * 256 * K * 2; return true;
    }
    static constexpr bool GATHER = false;
    __device__ __forceinline__ void aoffs(const Unit&, int tid, unsigned (&off)[2][2]) const {
#pragma unroll
        for (int i = 0; i < 2; ++i) { int R, C; stage_rc(tid * 16 + i * 8192, R, C);
#pragma unroll
            for (int h = 0; h < 2; ++h) off[h][i] = (unsigned)((R * K + C) * 2); }
    }
};
template <bool GATHER_> struct MoeSched {
    static constexpr bool GATHER = GATHER_;
    int cntE, pendI, ebaseE, R, NT, G, c, K, lane; const char* Abase; const char* Wbase; size_t wstride; const int* LIST;
    __device__ __forceinline__ bool next(int i, Unit& u) const {
        int rtg, pn;
        if (G == 256) { const int x = c & 7, j = c >> 3, rpx = 32 / NT; rtg = (i * 8 + x) * rpx + j / NT; pn = j % NT; }
        else { const long L = (long)i * G + c; rtg = (int)(L / NT); pn = (int)(L % NT); }
        if (rtg >= R) return false;
        const int e = __popcll(__ballot(lane < 32 && pendI <= rtg));
        const int tstart = e > 0 ? __builtin_amdgcn_readlane(pendI, e - 1) : 0, rt = rtg - tstart, ne = __builtin_amdgcn_readlane(cntE, e), eb = __builtin_amdgcn_readlane(ebaseE, e);
        u.e = e; u.pm = rt; u.pn = pn; u.nv = (ne - 256 * rt) < 256 ? (ne - 256 * rt) : 256; u.rb = eb + 256 * rt;
        u.B = Wbase + (size_t)e * wstride + (size_t)pn * 256 * K * 2;
        u.A = GATHER ? Abase : Abase + (size_t)u.rb * K * 2;
        return true;
    }
    __device__ __forceinline__ void aoffs(const Unit& u, int tid, unsigned (&off)[2][2]) const {
#pragma unroll
        for (int i = 0; i < 2; ++i) { int R, C; stage_rc(tid * 16 + i * 8192, R, C);
#pragma unroll
            for (int h = 0; h < 2; ++h) {
                if (GATHER) { int r = h * HALF + R; r = r < u.nv ? r : u.nv - 1; const unsigned slot = ((const unsigned*)LIST)[2 * ((size_t)u.e * T + u.pm * 256 + r)]; unsigned tok = slot >> 2; tok = tok < (unsigned)T ? tok : (unsigned)(T - 1);
                    off[h][i] = tok * (unsigned)(K * 2) + (unsigned)(C * 2); }
                else off[h][i] = (unsigned)((R * K + C) * 2);
            } }
    }
};

struct EpiBf16Out {
    static constexpr bool PERM = true; static constexpr bool BIAS_LDS = false;
    bf16* O; int ldc; int sc_lo, sc_hi; float scale;
    __device__ __forceinline__ void operator()(const f32x4 (&acc)[2][2][4][2], const Unit& u, int wr, int wc, int fr, int fq) const {
        const int row0 = u.pm * BM + wr * 64 + fr, col0 = u.pn * BM + wc * 32 + 8 * fq;
        const float sc = (u.pn >= sc_lo && u.pn < sc_hi) ? scale : 1.f;
#pragma unroll
        for (int ai = 0; ai < 2; ++ai)
#pragma unroll
            for (int m = 0; m < 4; ++m) { bf16* rowp = O + (size_t)(row0 + ai * HALF + m * 16) * ldc + col0;
#pragma unroll
                for (int bj = 0; bj < 2; ++bj) { const f32x4 v0 = acc[ai][bj][m][0] * sc, v1 = acc[ai][bj][m][1] * sc;
                    u32x4 w; w.x = cvt_pk_bf16(v0[0], v0[1]); w.y = cvt_pk_bf16(v0[2], v0[3]); w.z = cvt_pk_bf16(v1[0], v1[1]); w.w = cvt_pk_bf16(v1[2], v1[3]);
                    *(u32x4*)(rowp + bj * HALF) = w; } }
    }
};
struct EpiProj {
    static constexpr bool PERM = true; static constexpr bool BIAS_LDS = false;
    bf16* O; unsigned* NRM;
    bf16* CQN; bf16* CKVN; bf16* KR; float* LF; float* CS; const float* COS; const float* SIN; const float* gq; const float* gkv; const float* bfg;
    LAS float* P;
    __device__ __forceinline__ void operator()(const f32x4 (&acc)[2][2][4][2], const Unit& u, int wr, int wc, int fr, int fq) const {
        if (u.pn < 2) {
            const int nbj = u.pn == 0 ? 2 : 1;
#pragma unroll
            for (int ai = 0; ai < 2; ++ai)
#pragma unroll
                for (int m = 0; m < 4; ++m) { float s = 0.f;
#pragma unroll
                    for (int bj = 0; bj < 2; ++bj) if (bj < nbj) {
#pragma unroll
                        for (int n = 0; n < 2; ++n) { const f32x4 v = acc[ai][bj][m][n]; s += (v[0] * v[0] + v[1] * v[1]) + (v[2] * v[2] + v[3] * v[3]); } }
                    s += __shfl_xor(s, 16); s += __shfl_xor(s, 32);
                    if (fq == 0) P[(ai * HALF + wr * 64 + m * 16 + fr) * 4 + wc] = s; }
            asm volatile("s_waitcnt lgkmcnt(0)\n\ts_barrier" ::: "memory");
            const float invn = u.pn == 0 ? 1.f / 256.f : 1.f / 128.f;
#pragma unroll
            for (int ai = 0; ai < 2; ++ai)
#pragma unroll
                for (int m = 0; m < 4; ++m) { const int row = ai * HALF + wr * 64 + m * 16 + fr; const size_t t = (size_t)u.pm * BM + row;
                    const f32x4 p = *(const LAS f32x4*)(P + row * 4); const float rstd = 1.f / sqrtf(((p[0] + p[1]) + (p[2] + p[3])) * invn + RMS_EPS);
#pragma unroll
                    for (int bj = 0; bj < 2; ++bj) if (bj < nbj) { const int col = bj * HALF + wc * 32 + 8 * fq; const float* gp = (u.pn == 0 ? gq : gkv) + col;
                        const f32x4 g0 = *(const f32x4*)gp, g1 = *(const f32x4*)(gp + 4); const f32x4 v0 = acc[ai][bj][m][0] * rstd * g0, v1 = acc[ai][bj][m][1] * rstd * g1;
                        u32x4 w; w.x = cvt_pk_bf16(v0[0], v0[1]); w.y = cvt_pk_bf16(v0[2], v0[3]); w.z = cvt_pk_bf16(v1[0], v1[1]); w.w = cvt_pk_bf16(v1[2], v1[3]);
                        if (u.pn == 0) *(u32x4*)(CQN + t * 256 + col) = w; else *(u32x4*)(CKVN + t * 128 + col) = w; } }
            if (u.pn == 1 && wc == 0) {
#pragma unroll
                for (int ai = 0; ai < 2; ++ai)
#pragma unroll
                    for (int m = 0; m < 4; ++m) { const size_t t = (size_t)u.pm * BM + ai * HALF + wr * 64 + m * 16 + fr;
                        const f32x4 cs0 = *(const f32x4*)(COS + t * 16 + 8 * (fq & 1)), cs1 = *(const f32x4*)(COS + t * 16 + 8 * (fq & 1) + 4), sn0 = *(const f32x4*)(SIN + t * 16 + 8 * (fq & 1)), sn1 = *(const f32x4*)(SIN + t * 16 + 8 * (fq & 1) + 4);
                        float o[8];
#pragma unroll
                        for (int n = 0; n < 2; ++n)
#pragma unroll
                            for (int i = 0; i < 4; ++i) { const float v = acc[ai][1][m][n][i], w = __shfl_xor(v, 32); const float cs = n ? cs1[i] : cs0[i], sn = n ? sn1[i] : sn0[i];
                                o[n * 4 + i] = fq < 2 ? v * cs - w * sn : w * sn + v * cs; }
                        u32x4 w; w.x = cvt_pk_bf16(o[0], o[1]); w.y = cvt_pk_bf16(o[2], o[3]); w.z = cvt_pk_bf16(o[4], o[5]); w.w = cvt_pk_bf16(o[6], o[7]);
                        *(u32x4*)(KR + t * 32 + 8 * fq) = w; }
            }
            if (u.pn == 1 && wc == 1) {
                const f32x4 b0 = *(const f32x4*)bfg, b1 = *(const f32x4*)(bfg + 4);
#pragma unroll
                for (int ai = 0; ai < 2; ++ai)
#pragma unroll
                    for (int m = 0; m < 4; ++m) { const size_t t = (size_t)u.pm * BM + ai * HALF + wr * 64 + m * 16 + fr; float lf[8];
#pragma unroll
                        for (int n = 0; n < 2; ++n)
#pragma unroll
                            for (int i = 0; i < 4; ++i) { const float z = acc[ai][1][m][n][i] + (n ? b1[i] : b0[i]);
                                float ls = fminf(z, 0.f) - __logf(1.f + __expf(-fabsf(z)));
#pragma unroll
                                for (int o2 = 1; o2 < 16; o2 <<= 1) { const float up = __shfl_up(ls, o2, 16); if (fr >= o2) ls += up; }
                                lf[n * 4 + i] = ls; }
                        if (fq == 0) { *(f32x4*)(LF + t * 8) = (f32x4){lf[0], lf[1], lf[2], lf[3]}; *(f32x4*)(LF + t * 8 + 4) = (f32x4){lf[4], lf[5], lf[6], lf[7]};
                            if (fr == 15) { float* c = CS + (t >> 4) * 8; *(f32x4*)c = (f32x4){lf[0], lf[1], lf[2], lf[3]}; *(f32x4*)(c + 4) = (f32x4){lf[4], lf[5], lf[6], lf[7]}; } } }
            }
            return;
        }
        const int row0 = u.pm * BM + wr * 64 + fr, col0 = u.pn * BM + wc * 32 + 8 * fq;
        const float sc = (u.pn == 2 || u.pn == 3) ? C2F : 1.f; const bool nrm = u.pn < 6;
        float mx[2] = {0.f, 0.f};
#pragma unroll
        for (int ai = 0; ai < 2; ++ai)
#pragma unroll
            for (int m = 0; m < 4; ++m) { bf16* rowp = O + (size_t)(row0 + ai * HALF + m * 16) * PW + col0;
#pragma unroll
                for (int bj = 0; bj < 2; ++bj) { const f32x4 v0 = acc[ai][bj][m][0] * sc, v1 = acc[ai][bj][m][1] * sc;
                    u32x4 w; w.x = cvt_pk_bf16(v0[0], v0[1]); w.y = cvt_pk_bf16(v0[2], v0[3]); w.z = cvt_pk_bf16(v1[0], v1[1]); w.w = cvt_pk_bf16(v1[2], v1[3]);
                    *(u32x4*)(rowp + bj * HALF) = w;
                    if (nrm) { float s = 0.f;
#pragma unroll
                        for (int i = 0; i < 4; ++i) { const unsigned ww = i == 0 ? w.x : i == 1 ? w.y : i == 2 ? w.z : w.w; const float lo = __uint_as_float(ww << 16), hi = __uint_as_float(ww & 0xffff0000u); s += lo * lo + hi * hi; }
                        s += __shfl_xor(s, 16); s += __shfl_xor(s, 32);
                        mx[bj] = fmaxf(mx[bj], s); } } }
        if (nrm) {
#pragma unroll
            for (int bj = 0; bj < 2; ++bj) { float v = mx[bj];
#pragma unroll
                for (int o = 1; o < 16; o <<= 1) v = fmaxf(v, __shfl_xor(v, o));
                if (fr == 0 && fq == 0) { const int kind = u.pn >= 4, head = (u.pn & 1) * 4 + bj * 2 + (wc >> 1), half = wc & 1, b = u.pm / (SEQ / BM);
                    __hip_atomic_fetch_max(NRM + ((kind * NB + b) * 8 + head) * 2 + half, __float_as_uint(v), __ATOMIC_RELAXED, __HIP_MEMORY_SCOPE_AGENT); } }
        }
    }
};
struct EpiQ {
    static constexpr bool PERM = false; static constexpr bool BIAS_LDS = false;
    bf16* QM; const float* COS; const float* SIN;
    __device__ __forceinline__ void operator()(const f32x4 (&acc)[2][2][4][2], const Unit& u, int wr, int wc, int fr, int fq) const {
#pragma unroll
        for (int bj = 0; bj < 2; ++bj) {
            const int c0 = u.pn * BM + bj * HALF + wc * 32; const bool rope = (c0 % 96) == 64;
#pragma unroll
            for (int ai = 0; ai < 2; ++ai)
#pragma unroll
                for (int m = 0; m < 4; ++m) { const int t = u.pm * BM + ai * HALF + wr * 64 + m * 16 + fr;
                    f32x4 x1 = acc[ai][bj][m][0], x2 = acc[ai][bj][m][1];
                    if (rope) { const f32x4 cs = *(const f32x4*)(COS + (size_t)t * 16 + 4 * fq), sn = *(const f32x4*)(SIN + (size_t)t * 16 + 4 * fq);
                        const f32x4 y1 = x1 * cs - x2 * sn, y2 = x1 * sn + x2 * cs; x1 = y1; x2 = y2; }
                    x1 = x1 * C2M; x2 = x2 * C2M;
                    bf16* p = QM + (size_t)t * QW + c0 + 4 * fq;
                    u32x2 w1, w2; w1.x = cvt_pk_bf16(x1[0], x1[1]); w1.y = cvt_pk_bf16(x1[2], x1[3]); w2.x = cvt_pk_bf16(x2[0], x2[1]); w2.y = cvt_pk_bf16(x2[2], x2[3]);
                    *(u32x2*)p = w1; *(u32x2*)(p + 16) = w2; }
        }
    }
};
__device__ __forceinline__ unsigned pk4_fp8(float a, float b, float c, float d) { unsigned w = 0; w = __builtin_amdgcn_cvt_pk_fp8_f32(a, b, w, false); w = __builtin_amdgcn_cvt_pk_fp8_f32(c, d, w, true); return w; }
__device__ __forceinline__ void st8x2_rows(unsigned char* base, size_t row_a, size_t row_b, bool ok_a, bool ok_b, int col0, int fq, u32x2 wa, u32x2 wb) {
    const bool odd = (fq & 1) != 0; const u32x2 send = odd ? wa : wb; u32x2 recv; recv.x = (unsigned)__shfl_xor((int)send.x, 16); recv.y = (unsigned)__shfl_xor((int)send.y, 16);
    u32x4 o; if (odd) { o.x = recv.x; o.y = recv.y; o.z = wb.x; o.w = wb.y; } else { o.x = wa.x; o.y = wa.y; o.z = recv.x; o.w = recv.y; }
    if (odd ? ok_b : ok_a) *(u32x4*)(base + (odd ? row_b : row_a) * D + col0 - (odd ? 8 : 0)) = o;
}
struct EpiGU8 {
    static constexpr bool PERM = true; static constexpr bool BIAS_LDS = true;
    unsigned char* ACT; const float* BG; float ws; const LAS float* BL;
    __device__ __forceinline__ const float* bias_src(const Unit& u, int j) const { return BG + (size_t)u.e * 2048 + (j >> 1) * 1024 + u.pn * 128 + (j & 1) * 64; }
    __device__ __forceinline__ void operator()(const f32x4 (&acc)[2][2][4][2], const Unit& u, int wr, int wc, int fr, int fq) const {
        const int f0 = u.pn * 128 + wc * 32 + 8 * fq; const LAS float* bp = BL + u.bs * 256 + wc * 32 + 8 * fq;
        const f32x4 bg0 = *(const LAS f32x4*)bp, bg1 = *(const LAS f32x4*)(bp + 4), bu0 = *(const LAS f32x4*)(bp + 128), bu1 = *(const LAS f32x4*)(bp + 132);
        u32x2 wv[2][4];
#pragma unroll
        for (int ai = 0; ai < 2; ++ai)
#pragma unroll
            for (int m = 0; m < 4; ++m) {
                float o[8];
#pragma unroll
                for (int n = 0; n < 2; ++n) { const f32x4 g4 = acc[ai][0][m][n] * ws + (n ? bg1 : bg0), u4 = acc[ai][1][m][n] * ws + (n ? bu1 : bu0);
#pragma unroll
                    for (int i = 0; i < 4; ++i) { const float gg = fminf(g4[i], 7.f), uu = fminf(fmaxf(u4[i], -7.f), 7.f);
                        const float sg = __builtin_amdgcn_rcpf(1.f + __builtin_amdgcn_exp2f(-1.702f * LOG2E * gg)); o[n * 4 + i] = (uu + 1.f) * gg * sg; } }
                wv[ai][m].x = pk4_fp8(o[0], o[1], o[2], o[3]); wv[ai][m].y = pk4_fp8(o[4], o[5], o[6], o[7]); }
#pragma unroll
        for (int ai = 0; ai < 2; ++ai)
#pragma unroll
            for (int m = 0; m < 4; m += 2) { const size_t ra = (size_t)(u.rb + ai * HALF + wr * 64 + m * 16 + fr); st8x2_rows(ACT, ra, ra + 16, true, true, f0, fq, wv[ai][m], wv[ai][m + 1]); }
    }
};
struct EpiDown {
    static constexpr bool PERM = true; static constexpr bool BIAS_LDS = true;
    unsigned char* Y; const float* BD; float ws; const LAS float* BL;
    __device__ __forceinline__ const float* bias_src(const Unit& u, int j) const { return BD + (size_t)u.e * D + u.pn * BM + j * 64; }
    __device__ __forceinline__ void operator()(const f32x4 (&acc)[2][2][4][2], const Unit& u, int wr, int wc, int fr, int fq) const {
        const int col0 = u.pn * BM + wc * 32 + 8 * fq; const LAS float* bp = BL + u.bs * 256 + wc * 32 + 8 * fq; const float s = ws * Y8_SCALE;
        f32x4 bv[2][2];
#pragma unroll
        for (int bj = 0; bj < 2; ++bj) { bv[bj][0] = *(const LAS f32x4*)(bp + bj * HALF) * Y8_SCALE; bv[bj][1] = *(const LAS f32x4*)(bp + bj * HALF + 4) * Y8_SCALE; }
#define Y8C(x) __builtin_amdgcn_fmed3f((x), -448.f, 448.f)
#pragma unroll
        for (int ai = 0; ai < 2; ++ai)
#pragma unroll
            for (int bj = 0; bj < 2; ++bj) { u32x2 wv[4];
#pragma unroll
                for (int m = 0; m < 4; ++m) { const f32x4 v0 = acc[ai][bj][m][0] * s + bv[bj][0], v1 = acc[ai][bj][m][1] * s + bv[bj][1];
                    wv[m].x = pk4_fp8(Y8C(v0[0]), Y8C(v0[1]), Y8C(v0[2]), Y8C(v0[3])); wv[m].y = pk4_fp8(Y8C(v1[0]), Y8C(v1[1]), Y8C(v1[2]), Y8C(v1[3])); }
#pragma unroll
                for (int m = 0; m < 4; m += 2) { const int r = ai * HALF + wr * 64 + m * 16 + fr;
                    st8x2_rows(Y, (size_t)(u.rb + r), (size_t)(u.rb + r + 16), r < u.nv, r + 16 < u.nv, col0 + bj * HALF, fq, wv[m], wv[m + 1]); } }
#undef Y8C
    }
};
}


namespace attn {
using bf16x8 = __attribute__((ext_vector_type(8))) short;
using s16x4 = __attribute__((ext_vector_type(4))) short;
using f32x16 = __attribute__((ext_vector_type(16))) float;
constexpr int SEQL = SEQ, NW = 8, QBLK = 32, QB = QBLK * NW, KVBLK = 64;
constexpr int NSLOT = 3, SLOTB = 12288;
constexpr int LDS_K = 0, LDS_V = NSLOT * SLOTB, LDS_WS = 2 * NSLOT * SLOTB, LDS_OST = LDS_WS + NW * 64 * 4, LDS_QX = LDS_OST + NW * 4096, LDS_BYTES = LDS_QX + NW * 2048;
__device__ __forceinline__ int crow(int r, int hi) { return (r & 3) + 8 * (r >> 2) + 4 * hi; }
#define SBAR() __builtin_amdgcn_sched_barrier(0)
__device__ __forceinline__ void cmask(f32x16& p0, f32x16& p1, int jb, int qrel, int hi) {
    const float NEG = -INFINITY; const int kb = 64 * jb + 4 * hi;
#pragma unroll
    for (int r = 0; r < 16; ++r) { const int kv = kb + (r & 3) + 8 * (r >> 2); if (kv > qrel) p0[r] = NEG; if (kv + 32 > qrel) p1[r] = NEG; }
}
__device__ __forceinline__ void glds16(const void* gsrc, unsigned lds_dst) { unsigned keep;
    asm volatile("s_mov_b32 %0, m0\n\ts_mov_b32 m0, %2\n\ts_nop 0\n\tglobal_load_lds_dwordx4 %1, off\n\ts_mov_b32 m0, %0" : "=&s"(keep) : "v"(gsrc), "s"(lds_dst) : "memory"); }
__device__ __forceinline__ void glds16u(const char* sbase, unsigned voff, unsigned lds_dst) { unsigned keep;
    asm volatile("s_mov_b32 %0, m0\n\ts_mov_b32 m0, %3\n\ts_nop 2\n\tglobal_load_lds_dwordx4 %1, %2\n\ts_mov_b32 m0, %0" : "=&s"(keep) : "v"(voff), "s"(sbase), "s"(lds_dst) : "memory"); }
__device__ __forceinline__ float max3f(float a, float b, float c) { float r; asm("v_max3_f32 %0, %1, %2, %3" : "=v"(r) : "v"(a), "v"(b), "v"(c)); return r; }
__device__ __forceinline__ float max2f(float a, float b) { float r; asm("v_max_f32_e32 %0, %1, %2" : "=v"(r) : "v"(a), "v"(b)); return r; }
__device__ __forceinline__ float fadd_s(float a, float b) { float r; asm("v_add_f32_e32 %0, %1, %2" : "=v"(r) : "v"(a), "v"(b)); return r; }
__device__ __forceinline__ float fsub_s(float a, float b) { float r; asm("v_sub_f32_e32 %0, %1, %2" : "=v"(r) : "v"(a), "v"(b)); return r; }
typedef float f32x2_t __attribute__((ext_vector_type(2))); typedef __bf16 bf16x2_t __attribute__((ext_vector_type(2)));
__device__ __forceinline__ unsigned cvtpk_s(float lo, float hi) { f32x2_t v = {lo, hi}; bf16x2_t b = __builtin_convertvector(v, bf16x2_t); return __builtin_bit_cast(unsigned, b); }
#define WAIT_BAR(N) asm volatile("s_waitcnt vmcnt(" #N ") lgkmcnt(0)\n\ts_barrier" ::: "memory")
typedef __attribute__((address_space(3))) const char* lds_cptr;
typedef short v4i16_t __attribute__((ext_vector_type(4)));
#define LDSF(p) (*(const __attribute__((address_space(3))) bf16x8*)(p))
__device__ __forceinline__ void kload2(bf16x8* kf, lds_cptr kp, int j) { kf[2 * j] = LDSF(kp + j * 2048); kf[2 * j + 1] = LDSF(kp + j * 2048 + 512); }
__device__ __forceinline__ s16x4 vtr(lds_cptr p) { return __builtin_bit_cast(s16x4, __builtin_amdgcn_ds_read_tr16_b64_v4i16((__attribute__((address_space(3))) v4i16_t*)p)); }
__device__ __forceinline__ float rowmax(const f32x16& p0, const f32x16& p1) {
    float a = max3f(p0[0], p0[1], p1[0]), b = max3f(p0[2], p0[3], p1[1]); a = max3f(a, p1[2], p1[3]);
#pragma unroll
    for (int r = 4; r < 16; r += 4) { a = max3f(a, p0[r], p0[r + 1]); b = max3f(b, p0[r + 2], p0[r + 3]); a = max3f(a, p1[r], p1[r + 1]); b = max3f(b, p1[r + 2], p1[r + 3]); }
    const float m = max2f(a, b);
    auto rr = __builtin_amdgcn_permlane32_swap(__float_as_uint(m), __float_as_uint(m), false, false);
    return max2f(__uint_as_float(rr[0]), __uint_as_float(rr[1]));
}
__device__ __forceinline__ void pv(f32x16* o, int vb, bf16x8 pa0, bf16x8 pa1, bf16x8 pa2, bf16x8 pa3) {
#pragma unroll
    for (int d0 = 0; d0 < 2; ++d0) { s16x4 lo[4], hi[4];
#pragma unroll
        for (int ks = 0; ks < 4; ++ks) {
            asm volatile("ds_read_b64_tr_b16 %0,%1 offset:%c2" : "=&v"(lo[ks]) : "v"(vb), "i"(d0 * 4096 + ks * 1024) : "memory");
            asm volatile("ds_read_b64_tr_b16 %0,%1 offset:%c2" : "=&v"(hi[ks]) : "v"(vb), "i"(d0 * 4096 + ks * 1024 + 512) : "memory"); }
        asm volatile("s_waitcnt lgkmcnt(0)" ::: "memory"); SBAR();
#define PK(k) (bf16x8){lo[k][0], lo[k][1], lo[k][2], lo[k][3], hi[k][0], hi[k][1], hi[k][2], hi[k][3]}
        o[d0] = __builtin_amdgcn_mfma_f32_32x32x16_bf16(pa0, PK(0), o[d0], 0, 0, 0);
        o[d0] = __builtin_amdgcn_mfma_f32_32x32x16_bf16(pa1, PK(1), o[d0], 0, 0, 0);
        o[d0] = __builtin_amdgcn_mfma_f32_32x32x16_bf16(pa2, PK(2), o[d0], 0, 0, 0);
        o[d0] = __builtin_amdgcn_mfma_f32_32x32x16_bf16(pa3, PK(3), o[d0], 0, 0, 0);
#undef PK
    }
}
#define MF32(a, b, c) __builtin_amdgcn_mfma_f32_32x32x16_bf16(a, b, c, 0, 0, 0)

__device__ __forceinline__ float fox_prepass(int b, int h, int qb, unsigned char* ws, char* shm) {
    int tid = threadIdx.x; asm volatile("" : "+v"(tid));
    const int lane = tid & 63, r32 = lane & 31, hi = lane >> 5; const int wid = __builtin_amdgcn_readfirstlane(tid >> 6);
    const long rowbase = (long)b * SEQL; const int tw0 = qb * QB + wid * QBLK;
    const bf16* Qg = (const bf16*)(ws + WS_PROJ) + 512 + h * 64; const bf16* Kg = (const bf16*)(ws + WS_PROJ) + 1024 + h * 64; const bf16* Xg = (const bf16*)(ws + WS_KB) + h * 8;
    bf16x8 qr[4];
#pragma unroll
    for (int d0 = 0; d0 < 4; ++d0) qr[d0] = *reinterpret_cast<const bf16x8*>(&Qg[(rowbase + tw0 + r32) * PW + d0 * 16 + hi * 8]);
    const short one_ = hi ? (short)0 : (short)0x3F80; const bf16x8 qfox = (bf16x8){one_, one_, one_, 0, 0, 0, 0, 0};
    float rmax = -INFINITY;
#pragma unroll
    for (int kt = 0; kt < 3; ++kt) {
        const int k0 = tw0 - 64 + 32 * kt; int key = k0 + r32; key = key < 0 ? 0 : key;
        const bf16* kp = Kg + (rowbase + key) * PW + hi * 8;
        f32x16 sc = f32x16{};
#pragma unroll
        for (int d0 = 0; d0 < 4; ++d0) sc = MF32(*reinterpret_cast<const bf16x8*>(kp + d0 * 16), qr[d0], sc);
        sc = MF32(*reinterpret_cast<const bf16x8*>(Xg + (rowbase + key) * 64), qfox, sc);
#pragma unroll
        for (int r = 0; r < 16; ++r) { const int kk = k0 + crow(r, hi); rmax = __builtin_fmaxf(rmax, (kk >= 0 && kk <= tw0 + r32) ? sc[r] : -INFINITY); }
    }
    rmax = __builtin_fmaxf(rmax, __shfl_xor(rmax, 32));
    float v = rmax;
#pragma unroll
    for (int o = 16; o >= 1; o >>= 1) v = __builtin_fminf(v, __shfl_xor(v, o));
    float* wsall = (float*)(shm + LDS_WS);
    if (lane == 0) wsall[wid * 64] = v;
    __syncthreads();
    float g = wsall[0];
#pragma unroll
    for (int w = 1; w < NW; ++w) g = __builtin_fminf(g, wsall[w * 64]);
    __syncthreads();
    return -g;
}

template <bool MLA, int THRL>
__device__ __forceinline__ void attn_unit(int b, int h, int qb, unsigned char* ws, char* shm, int n0 = 0) {
    constexpr int QP = MLA ? QW : PW, KP = MLA ? KVW : PW, VP = KP, XP = MLA ? 32 : 64, NXS = MLA ? 2 : 1, NXW = MLA ? 4 : 1;
    int tid = threadIdx.x; asm volatile("" : "+v"(tid));
    const int lane = tid & 63, r32 = lane & 31, hi = lane >> 5; const int wid = __builtin_amdgcn_readfirstlane(tid >> 6);
    const long rowbase = (long)b * SEQL; const int q0 = qb * QB;
    const bf16* Qb = MLA ? (const bf16*)(ws + WS_QM) + h * 96 : (const bf16*)(ws + WS_PROJ) + 512 + h * 64;
    const bf16* Kb = MLA ? (const bf16*)(ws + WS_KV) + h * 128 : (const bf16*)(ws + WS_PROJ) + 1024 + h * 64;
    const bf16* Vb = MLA ? (const bf16*)(ws + WS_KV) + h * 128 + 64 : (const bf16*)(ws + WS_PROJ) + 1536 + h * 64;
    const bf16* Xb = MLA ? (const bf16*)(ws + WS_KR) : (const bf16*)(ws + WS_KB) + h * 8;
    const bf16* Qw = Qb + (rowbase + q0 + wid * QBLK) * QP;
    const unsigned lds0 = (unsigned)(uintptr_t)shm; const lds_cptr shm3 = (lds_cptr)shm;
    float* wsf = (float*)(shm + LDS_WS) + wid * 64;
    const unsigned kvoff = (unsigned)((lane * KP + wid * 8) * 2);
    const unsigned vvoff = (unsigned)(((16 * (wid & 3) + (lane >> 2)) * VP + (wid >> 2) * 32 + (lane & 3) * 8) * 2);
    const unsigned xvoff = (unsigned)((lane * XP + (MLA ? wid * 8 : 0)) * 2);
    const long kr0 = rowbase + (long)n0 * KVBLK;
    const char* kbase = g8::uni_ptr((const char*)(Kb + kr0 * KP)); const char* vbase = g8::uni_ptr((const char*)(Vb + kr0 * VP)); const char* xbase = g8::uni_ptr((const char*)(Xb + kr0 * XP));
    const unsigned kdst = lds0 + LDS_K + wid * 1024, vdst = lds0 + LDS_V + wid * 1024, xdst = lds0 + LDS_K + 8192 + wid * 1024;
#define DMA_K(t, slot) glds16u(g8::uni_ptr(kbase + (size_t)(t) * (KVBLK * KP * 2)), kvoff, (unsigned)__builtin_amdgcn_readfirstlane(kdst + (slot)))
#define DMA_V(t, slot) glds16u(g8::uni_ptr(vbase + (size_t)(t) * (KVBLK * VP * 2)), vvoff, (unsigned)__builtin_amdgcn_readfirstlane(vdst + (slot)))
#define DMA_X(t, slot) do { if (wid < NXW) glds16u(g8::uni_ptr(xbase + (size_t)(t) * (KVBLK * XP * 2)), xvoff, (unsigned)__builtin_amdgcn_readfirstlane(xdst + (slot))); } while (0)
    const int vb0 = (int)(lds0 + LDS_V) + ((lane >> 4) & 1) * 32 + (lane & 3) * 8 + (4 * hi + ((lane & 15) >> 2)) * 64;
    const char* Kbase = shm + LDS_K; bf16x8 kf[8];
    const lds_cptr kp0 = shm3 + LDS_K + hi * 1024 + r32 * 16;
    const lds_cptr kxp0 = shm3 + LDS_K + 8192 + (MLA ? hi * 1024 : 0) + r32 * 16;
    const lds_cptr vp0 = shm3 + LDS_V + ((lane >> 4) & 1) * 32 + (lane & 3) * 8 + (4 * hi + ((lane & 15) >> 2)) * 64;
    const int NT = (q0 + QB) / KVBLK - n0;
    DMA_K(0, 0); DMA_X(0, 0); DMA_V(0, 0); DMA_K(1, SLOTB); DMA_X(1, SLOTB);
    bf16x8 qr[4];
#pragma unroll
    for (int d0 = 0; d0 < 4; ++d0) qr[d0] = *reinterpret_cast<const bf16x8*>(&Qw[(long)r32 * QP + d0 * 16 + hi * 8]);
    const lds_cptr qxp = shm3 + LDS_QX + wid * 2048 + hi * 512 + r32 * 16;
    if (MLA) {
#pragma unroll
        for (int xs = 0; xs < NXS; ++xs) { const bf16x8 v = *reinterpret_cast<const bf16x8*>(&Qw[(long)r32 * QP + 64 + xs * 16 + hi * 8]);
            *(__attribute__((address_space(3))) bf16x8*)(shm3 + LDS_QX + wid * 2048 + xs * 1024 + hi * 512 + r32 * 16) = v; }
    }
    const short one_ = hi ? (short)0 : (short)0x3F80; const bf16x8 qfox = (bf16x8){one_, one_, one_, 0, 0, 0, 0, 0};
#define QX(xs) (MLA ? LDSF(qxp + (xs) * 1024) : qfox)
    const float ft = MLA ? 0.f : ((const float*)(ws + WS_FT))[(rowbase + q0 + wid * QBLK + r32) * 8 + h];
    float mhat = 0.f, l_reg = 0.f; f32x16 o[2]; o[0] = f32x16{}; o[1] = f32x16{}; f32x16 negm;
#pragma unroll
    for (int r = 0; r < 16; ++r) negm[r] = ft;
    asm volatile("" : "+v"(negm));
    const int qrel = wid * QBLK + r32;
#define CMASK(P0, P1, t) do { int jb_ = (t) - (NT - 4); if (jb_ >= 0) cmask(P0, P1, jb_, qrel, hi); } while (0)
    bool resc = false;
#define START(P0, P1) do { const float rm = rowmax(P0, P1); resc = false; \
    { const float dl = MLA ? rm : (__any(rm > (float)THRL) ? __builtin_fmaxf(rm, 0.f) : 0.f);     \
      mhat = fadd_s(mhat, dl); \
      _Pragma("unroll") for (int r = 0; r < 16; ++r) { P0[r] = fsub_s(P0[r], dl); P1[r] = fsub_s(P1[r], dl); } \
      _Pragma("unroll") for (int r = 0; r < 16; ++r) negm[r] = ft - mhat; asm volatile("" : "+v"(negm)); } \
    _Pragma("unroll") for (int r = 0; r < 16; ++r) P0[r] = __builtin_amdgcn_exp2f(P0[r]); } while (0)
#define RESC() do { if (resc) { asm volatile("s_waitcnt lgkmcnt(0)" ::: "memory"); \
      _Pragma("unroll") for (int d_ = 0; d_ < 2; ++d_) _Pragma("unroll") for (int r = 0; r < 16; ++r) o[d_][r] *= wsf[crow(r, hi)]; } } while (0)
    f32x16 pA0, pA1, pB0, pB1;
    int sl_prev = 0, sl_cur = 0, sl_next = SLOTB;
#define ROT() do { sl_prev = sl_cur; sl_cur = sl_next; sl_next = (sl_next == (NSLOT - 1) * SLOTB) ? 0 : sl_next + SLOTB; } while (0)
    DMA_K(2, 2 * SLOTB); DMA_X(2, 2 * SLOTB);
    WAIT_BAR(0);
    { bf16x8 kx[2 * NXS];
      const char* kb = Kbase + hi * 1024 + r32 * 16;
#pragma unroll
      for (int d0 = 0; d0 < 4; ++d0) {
          const bf16x8 b0 = *reinterpret_cast<const bf16x8*>(kb + d0 * 2048);
          const bf16x8 b1 = *reinterpret_cast<const bf16x8*>(kb + d0 * 2048 + 512);
          if (d0 == 0) { pA0 = MF32(b0, qr[0], negm); pA1 = MF32(b1, qr[0], negm); }
          else { pA0 = MF32(b0, qr[d0], pA0); pA1 = MF32(b1, qr[d0], pA1); } }
#pragma unroll
      for (int xs = 0; xs < NXS; ++xs) { kx[2 * xs] = LDSF(kxp0 + xs * 2048); kx[2 * xs + 1] = LDSF(kxp0 + xs * 2048 + 512);
          const bf16x8 qq = QX(xs); pA0 = MF32(kx[2 * xs], qq, pA0); pA1 = MF32(kx[2 * xs + 1], qq, pA1); } }
    asm volatile("s_nop 15\n\ts_nop 7" : "+v"(pA0), "+v"(pA1)); CMASK(pA0, pA1, 0);
    START(pA0, pA1);
    _Pragma("unroll") for (int r = 0; r < 16; ++r) pA1[r] = __builtin_amdgcn_exp2f(pA1[r]);
    WAIT_BAR(0);
    DMA_K(3, 0); DMA_V(1, SLOTB);
    ROT();
    { _Pragma("unroll") for (int j = 0; j < 4; ++j) kload2(kf, kp0 + sl_cur, j); }
    WAIT_BAR(2);
    s16x4 vlo[8], vhi[8]; u32x4 pw0, pw1, pw2, pw3;
#define PKW(P, B) cvtpk_s(P[B], P[B + 1])
#define PAF(k) __builtin_bit_cast(bf16x8, pw##k)
#define VFR(i) (bf16x8){vlo[i][0], vlo[i][1], vlo[i][2], vlo[i][3], vhi[i][0], vhi[i][1], vhi[i][2], vhi[i][3]}
#define PIN(x) asm volatile("" : "+v"(x))
#define MX3(a, b, c) __builtin_fmaxf(__builtin_fmaxf((a), (b)), (c))
#define GAPA(MFX, A0, A1, A2, A3, W0, W1, PW) do { MFX; sacc += A0; sacc += A1; sacc += A2; sacc += A3; PIN(sacc); W0; W1; PIN(PW); SBAR(); } while (0)
#define EX(v) __builtin_amdgcn_exp2f(v)
#define GAPB(MFX, X, B) do { MFX; X[B] = EX(X[B]); X[B + 1] = EX(X[B + 1]); X[B + 2] = EX(X[B + 2]); X[B + 3] = EX(X[B + 3]); PIN(X); SBAR(); } while (0)
#define VRD(i) do { vlo[i] = vtr(vp_ + (((i) >> 2) * 4096 + ((i) & 3) * 1024)); vhi[i] = vtr(vp_ + (((i) >> 2) * 4096 + ((i) & 3) * 1024 + 512)); } while (0)
#define KRD(G, j) do { if (G) { kload2(kf, kp0 + sl_next, j); SBAR(); } } while (0)
#define STEP(C0, C1, P0, P1, t, GX, GK, GV, GL) do { SBAR(); \
    if (GX) { DMA_X((t) + 2, sl_prev); } \
    const lds_cptr vp_ = vp0 + sl_prev; const lds_cptr kxp_ = kxp0 + sl_cur; bf16x8 kx[2 * NXS]; \
    VRD(0); SBAR(); float sacc = (P0[0] + P0[1]); \
    GAPA(C0 = MF32(kf[0], qr[0], negm), P0[2], P0[3], P0[4], P0[5],     pw0[0] = PKW(P0, 0), pw0[1] = PKW(P0, 2), pw0); \
    VRD(4); SBAR(); GAPA(C1 = MF32(kf[1], qr[0], negm), P0[6], P0[7], P0[8], P0[9],     pw0[2] = PKW(P0, 4), pw0[3] = PKW(P0, 6), pw0); \
    VRD(1); SBAR(); GAPA(C0 = MF32(kf[2], qr[1], C0),   P0[10], P0[11], P0[12], P0[13], pw1[0] = PKW(P0, 8), pw1[1] = PKW(P0, 10), pw1); \
    VRD(5); SBAR(); GAPA(C1 = MF32(kf[3], qr[1], C1),   P0[14], P0[15], P1[0], P1[1],   pw1[2] = PKW(P0, 12), pw1[3] = PKW(P0, 14), pw1); \
    kx[0] = LDSF(kxp_); kx[1] = LDSF(kxp_ + 512); SBAR(); \
    VRD(2); SBAR(); GAPA(C0 = MF32(kf[4], qr[2], C0),   P1[2], P1[3], P1[4], P1[5],     pw2[0] = PKW(P1, 0), pw2[1] = PKW(P1, 2), pw2); \
    VRD(6); SBAR(); GAPA(C1 = MF32(kf[5], qr[2], C1),   P1[6], P1[7], P1[8], P1[9],     pw2[2] = PKW(P1, 4), pw2[3] = PKW(P1, 6), pw2); \
    if (NXS > 1) { kx[2 * (NXS - 1)] = LDSF(kxp_ + 2048); kx[2 * (NXS - 1) + 1] = LDSF(kxp_ + 2048 + 512); SBAR(); } \
    VRD(3); SBAR(); GAPA(C0 = MF32(kf[6], qr[3], C0),   P1[10], P1[11], P1[12], P1[13], pw3[0] = PKW(P1, 8), pw3[1] = PKW(P1, 10), pw3); \
    VRD(7); SBAR(); GAPA(C1 = MF32(kf[7], qr[3], C1),   P1[14], P1[15], 0.f, 0.f,       pw3[2] = PKW(P1, 12), pw3[3] = PKW(P1, 14), pw3); \
    { const bf16x8 qq = QX(0); C0 = MF32(kx[0], qq, C0); SBAR(); C1 = MF32(kx[1], qq, C1); SBAR(); } \
    if (NXS > 1) { const bf16x8 qq = QX(NXS - 1); C0 = MF32(kx[2 * (NXS - 1)], qq, C0); SBAR(); C1 = MF32(kx[2 * (NXS - 1) + 1], qq, C1); SBAR(); } \
    l_reg += sacc; \
    if (GK) { DMA_K((t) + 3, sl_cur); } if (GV) { DMA_V((t) + 1, sl_next); } \
    CMASK(C0, C1, t); \
    { float a = MX3(C0[0], C0[1], C1[0]), b_ = MX3(C0[2], C0[3], C1[1]); a = MX3(a, C1[2], C1[3]); \
      _Pragma("unroll") for (int r = 4; r < 16; r += 4) { a = MX3(a, C0[r], C0[r + 1]); b_ = MX3(b_, C0[r + 2], C0[r + 3]); a = MX3(a, C1[r], C1[r + 1]); b_ = MX3(b_, C1[r + 2], C1[r + 3]); } \
      float rm = __builtin_fmaxf(a, b_); { auto rr = __builtin_amdgcn_permlane32_swap(__float_as_uint(rm), __float_as_uint(rm), false, false); rm = __builtin_fmaxf(__uint_as_float(rr[0]), __uint_as_float(rr[1])); } \
      resc = false; \
      if (__builtin_expect(__any(rm > (float)THRL), 0)) { const float dl = __builtin_fmaxf(rm, 0.f); mhat += dl; \
        _Pragma("unroll") for (int r = 0; r < 16; ++r) { C0[r] -= dl; C1[r] -= dl; } \
        _Pragma("unroll") for (int r = 0; r < 16; ++r) negm[r] = ft - mhat; asm volatile("" : "+v"(negm)); \
        const float f = __builtin_amdgcn_exp2f(-dl); l_reg *= f; if (hi == 0) wsf[r32] = f; resc = true; } } \
    SBAR(); \
    GAPB(o[0] = MF32(PAF(0), VFR(0), o[0]), C0, 0); \
    GAPB(o[1] = MF32(PAF(0), VFR(4), o[1]), C0, 4); \
    KRD(GL, 0); GAPB(o[0] = MF32(PAF(1), VFR(1), o[0]), C0, 8); \
    KRD(GL, 1); GAPB(o[1] = MF32(PAF(1), VFR(5), o[1]), C0, 12); \
    KRD(GL, 2); GAPB(o[0] = MF32(PAF(2), VFR(2), o[0]), C1, 0); \
    KRD(GL, 3); GAPB(o[1] = MF32(PAF(2), VFR(6), o[1]), C1, 4); \
    GAPB(o[0] = MF32(PAF(3), VFR(3), o[0]), C1, 8); \
    GAPB(o[1] = MF32(PAF(3), VFR(7), o[1]), C1, 12); \
    } while (0)
    int t = 1;
#undef CMASK
#define CMASK(P0, P1, t) do { } while (0)
    for (; t + 5 < NT; t += 2) {
        STEP(pB0, pB1, pA0, pA1, t, true, true, true, true);     WAIT_BAR(2); RESC(); ROT();
        STEP(pA0, pA1, pB0, pB1, t + 1, true, true, true, true); WAIT_BAR(2); RESC(); ROT();
    }
#undef CMASK
#define CMASK(P0, P1, t) do { int jb_ = (t) - (NT - 4); if (jb_ >= 0) cmask(P0, P1, jb_, qrel, hi); } while (0)
#define ENDW(tt) do { if ((tt) + 3 < NT) { WAIT_BAR(2); } else if ((tt) + 2 < NT) { WAIT_BAR(1); } else { WAIT_BAR(0); } } while (0)
    for (; t + 1 < NT; t += 2) {
        STEP(pB0, pB1, pA0, pA1, t, (t + 2 < NT), (t + 3 < NT), (t + 1 < NT), (t + 1 < NT));         ENDW(t);     RESC(); ROT();
        STEP(pA0, pA1, pB0, pB1, t + 1, (t + 3 < NT), (t + 4 < NT), (t + 2 < NT), (t + 2 < NT));     ENDW(t + 1); RESC(); ROT();
    }
    STEP(pB0, pB1, pA0, pA1, NT - 1, false, false, false, false); RESC();
    { float sacc = pB0[0] + pB0[1];
      _Pragma("unroll") for (int r = 2; r < 16; ++r) sacc += pB0[r];
      _Pragma("unroll") for (int r = 0; r < 16; ++r) sacc += pB1[r];
      l_reg += sacc;
      pw0 = (u32x4){PKW(pB0, 0), PKW(pB0, 2), PKW(pB0, 4), PKW(pB0, 6)}; pw1 = (u32x4){PKW(pB0, 8), PKW(pB0, 10), PKW(pB0, 12), PKW(pB0, 14)};
      pw2 = (u32x4){PKW(pB1, 0), PKW(pB1, 2), PKW(pB1, 4), PKW(pB1, 6)}; pw3 = (u32x4){PKW(pB1, 8), PKW(pB1, 10), PKW(pB1, 12), PKW(pB1, 14)};
      SBAR(); pv(o, vb0 + sl_cur, PAF(0), PAF(1), PAF(2), PAF(3)); }
#undef PKW
#undef PAF
#undef VFR
#undef PIN
#undef MX3
#undef GAPA
#undef GAPB
#undef EX
#undef VRD
#undef KRD
#undef STEP
#undef ENDW
    { auto rr = __builtin_amdgcn_permlane32_swap(__float_as_uint(l_reg), __float_as_uint(l_reg), false, false); l_reg = __uint_as_float(rr[0]) + __uint_as_float(rr[1]); }
    if (hi == 0) wsf[32 + r32] = l_reg; asm volatile("s_waitcnt lgkmcnt(0)" ::: "memory");
    float rli[16];
#pragma unroll
    for (int r = 0; r < 16; ++r) rli[r] = __builtin_amdgcn_rcpf(wsf[32 + crow(r, hi)]);
    bf16* Ow = (bf16*)(ws + WS_O) + (rowbase + q0 + wid * QBLK) * D + (MLA ? 0 : 512) + h * 64;
    { bf16* stg = (bf16*)(shm + LDS_OST) + wid * 2048;
#pragma unroll
      for (int r = 0; r < 16; ++r) { const int orow = crow(r, hi);
#pragma unroll
          for (int d0 = 0; d0 < 2; ++d0) stg[orow * 64 + d0 * 32 + r32] = (bf16)f2bf(o[d0][r] * rli[r]); }
      asm volatile("s_waitcnt lgkmcnt(0)" ::: "memory");
#pragma unroll
      for (int i = 0; i < 4; ++i) { const int row = i * 8 + (lane >> 3), ch = lane & 7; const u32x4 v = *(const u32x4*)(stg + row * 64 + ch * 8); *(u32x4*)(Ow + (long)row * D + ch * 8) = v; } }
    asm volatile("s_waitcnt lgkmcnt(0)\n\ts_barrier" ::: "memory");
#undef DMA_K
#undef DMA_V
#undef DMA_X
#undef QX
#undef CMASK
#undef START
#undef RESC
#undef ROT
}
#undef SBAR
#undef WAIT_BAR
#undef LDSF
#undef MF32
}

template <class MapF>
__device__ __forceinline__ void transpose_item(const float* W, int K, int ldw, bf16* WT, LAS float* scr, int item, int nblk, int lane, MapF map) {
    const int kb = item / nblk, nb = item % nblk, k0 = 64 * kb, n0 = 32 * nb;
    const int src = map(n0 + (lane & 31)); const float* wp = W + (src < 0 ? 0 : src); const float wsc = src < 0 ? 0.f : 1.f;
#pragma unroll
    for (int i = 0; i < 32; ++i) { const int kk = 2 * i + (lane >> 5); scr[kk * 33 + (lane & 31)] = wp[(size_t)(k0 + kk) * ldw] * wsc; }
    asm volatile("s_waitcnt lgkmcnt(0)" ::: "memory");
    const int c = lane & 7;
#pragma unroll
    for (int j = 0; j < 4; ++j) { const int n = (lane >> 3) + 8 * j; const LAS float* s = scr + (8 * c) * 33 + n;
        u32x4 o; o.x = pk2(s[0 * 33], s[1 * 33]); o.y = pk2(s[2 * 33], s[3 * 33]); o.z = pk2(s[4 * 33], s[5 * 33]); o.w = pk2(s[6 * 33], s[7 * 33]);
        *(u32x4*)(WT + (size_t)(n0 + n) * K + k0 + 8 * c) = o; }
    asm volatile("s_waitcnt lgkmcnt(0)" ::: "memory");
}

struct TItem { bf16* WT; int K, k0, n0; float wsc; bool valid; };
template <typename MapF>
__device__ __forceinline__ void titem_load(const float* W, int K, int ldw, bf16* WT, int item, int nblk, int lane, MapF map, float (&tv)[32], TItem& ti) {
    const int kb = item / nblk, nb = item % nblk, k0 = 64 * kb, n0 = 32 * nb;
    const int src = map(n0 + (lane & 31)); const float* wp = W + (src < 0 ? 0 : src);
    ti.WT = WT; ti.K = K; ti.k0 = k0; ti.n0 = n0; ti.wsc = src < 0 ? 0.f : 1.f; ti.valid = true;
#pragma unroll
    for (int i = 0; i < 32; ++i) { const int kk = 2 * i + (lane >> 5); tv[i] = wp[(size_t)(k0 + kk) * ldw]; }
}
__device__ __forceinline__ void titem_finish(const float (&tv)[32], const TItem& ti, LAS float* scr, int lane) {
#pragma unroll
    for (int i = 0; i < 32; ++i) { const int kk = 2 * i + (lane >> 5); scr[kk * 33 + (lane & 31)] = tv[i] * ti.wsc; }
    asm volatile("s_waitcnt lgkmcnt(0)" ::: "memory");
    const int c = lane & 7;
#pragma unroll
    for (int j = 0; j < 4; ++j) { const int n = (lane >> 3) + 8 * j; const LAS float* q = scr + (8 * c) * 33 + n;
        u32x4 o; o.x = pk2(q[0 * 33], q[1 * 33]); o.y = pk2(q[2 * 33], q[3 * 33]); o.z = pk2(q[4 * 33], q[5 * 33]); o.w = pk2(q[6 * 33], q[7 * 33]);
        *(u32x4*)(ti.WT + (size_t)(ti.n0 + n) * ti.K + ti.k0 + 8 * c) = o; }
    asm volatile("s_waitcnt lgkmcnt(0)" ::: "memory");
}
__device__ __forceinline__ void f8x_item(const float* Wsrc, int ldw, unsigned char* WTdst, LAS unsigned char* tile, int lane, float sc) {
    const int nq = lane & 31, kr = lane >> 5;
    const float* wp = Wsrc + (size_t)(4 * kr) * ldw + 4 * nq;
    f32x4 va[4][4], vb[4][4];
#define F8X_LOAD(v, g2) do { _Pragma("unroll") for (int q = 0; q < 4; ++q) _Pragma("unroll") for (int j = 0; j < 4; ++j) v[q][j] = __builtin_nontemporal_load((const f32x4*)(wp + (size_t)(8 * ((g2) + q) + j) * ldw)); } while (0)
#define F8X_PACK(v, g2) do { _Pragma("unroll") for (int q = 0; q < 4; ++q) { const int kd = 2 * ((g2) + q) + kr; _Pragma("unroll") for (int c = 0; c < 4; ++c) \
        *(LAS unsigned*)(tile + (4 * nq + c) * 128 + 16 * ((kd >> 2) ^ (nq & 7)) + 4 * (kd & 3)) = g8::pk4_fp8(v[q][0][c] * sc, v[q][1][c] * sc, v[q][2][c] * sc, v[q][3][c] * sc); } } while (0)
    F8X_LOAD(va, 0); __builtin_amdgcn_sched_barrier(0);
    F8X_LOAD(vb, 4); __builtin_amdgcn_sched_barrier(0);
    F8X_PACK(va, 0); __builtin_amdgcn_sched_barrier(0);
    F8X_LOAD(va, 8); __builtin_amdgcn_sched_barrier(0);
    F8X_PACK(vb, 4); __builtin_amdgcn_sched_barrier(0);
    F8X_LOAD(vb, 12); __builtin_amdgcn_sched_barrier(0);
    F8X_PACK(va, 8); __builtin_amdgcn_sched_barrier(0);
    F8X_PACK(vb, 12);
#undef F8X_LOAD
#undef F8X_PACK
    asm volatile("s_waitcnt lgkmcnt(0)" ::: "memory");
    const int c8 = lane & 7;
#pragma unroll 4
    for (int jj = 0; jj < 16; ++jj) { const int n = (lane >> 3) + 8 * jj;
        const u32x4 o = *(const LAS u32x4*)(tile + n * 128 + 16 * (c8 ^ ((n >> 2) & 7)));
        __builtin_nontemporal_store(o, (u32x4*)(WTdst + (size_t)n * 1024 + 16 * c8)); }
    asm volatile("s_waitcnt lgkmcnt(0)" ::: "memory");
}
template <class MapF>
__device__ __forceinline__ void transpose_item_f8(const float* W, int K, int ldw, unsigned char* WT, LAS float* scr, int item, int nblk, int lane, float sc, MapF map) {
    const int kb = item / nblk, nb = item % nblk, k0 = 128 * kb, n0 = 32 * nb;
    const int src = map(n0 + (lane & 31)); const float* wp = W + src;
#pragma unroll 8
    for (int i = 0; i < 64; ++i) { const int kk = 2 * i + (lane >> 5); scr[kk * 33 + (lane & 31)] = __builtin_nontemporal_load(wp + (size_t)(k0 + kk) * ldw) * sc; }
    asm volatile("s_waitcnt lgkmcnt(0)" ::: "memory");
    const int c = lane & 7;
#pragma unroll
    for (int j = 0; j < 4; ++j) { const int n = (lane >> 3) + 8 * j; const LAS float* s = scr + (16 * c) * 33 + n;
        u32x4 o; o.x = g8::pk4_fp8(s[0 * 33], s[1 * 33], s[2 * 33], s[3 * 33]); o.y = g8::pk4_fp8(s[4 * 33], s[5 * 33], s[6 * 33], s[7 * 33]);
        o.z = g8::pk4_fp8(s[8 * 33], s[9 * 33], s[10 * 33], s[11 * 33]); o.w = g8::pk4_fp8(s[12 * 33], s[13 * 33], s[14 * 33], s[15 * 33]);
        __builtin_nontemporal_store(o, (u32x4*)(WT + (size_t)(n0 + n) * K + k0 + 16 * c)); }
    asm volatile("s_waitcnt lgkmcnt(0)" ::: "memory");
}

__device__ __forceinline__ void dephase(int n) { for (int i = 0; i < n; ++i) __builtin_amdgcn_s_sleep(1); }
__global__ void __launch_bounds__(512, 2) fwd(Args a) {
    extern __shared__ __attribute__((aligned(16))) unsigned char lds_raw[];
    LAS unsigned char* lds = (LAS unsigned char*)lds_raw;
    const int G = gridDim.x, NGW = G * 8;
    unsigned char* ws = a.ws;
    unsigned* ctl = (unsigned*)(ws + WS_CTL);
    volatile LAS unsigned* MISC = (volatile LAS unsigned*)(lds + MISC_OFF);
    if (threadIdx.x < 16) MISC[threadIdx.x] = 0u;
    __syncthreads();
#define PH_IDS int tid = threadIdx.x; asm volatile("" : "+v"(tid)); const int lane = tid & 63; const int wave = __builtin_amdgcn_readfirstlane(tid >> 6); const int gw = blockIdx.x * 8 + wave; (void)lane; (void)wave; (void)gw;
    XcdBarrier bar = xcd_barrier_post(ctl + CW_BAR, MISC);

#define XIN ((const float*)a.in[I_X])
#define ADA ((float*)(ws + WS_ADA))
#define COS ((float*)(ws + WS_COS))
#define SIN ((float*)(ws + WS_SIN))
#define LF ((float*)(ws + WS_LF))
#define FT ((float*)(ws + WS_FT))
#define KB ((bf16*)(ws + WS_KB))
#define KR ((bf16*)(ws + WS_KR))
#define TOPE ((int*)(ws + WS_TOPE))
#define TOPG ((float*)(ws + WS_TOPG))
#define LIST ((int*)(ws + WS_LIST))
#define H ((bf16*)(ws + WS_H))
#define PROJ ((bf16*)(ws + WS_PROJ))
#define CQN ((bf16*)(ws + WS_CQN))
#define CKVN ((bf16*)(ws + WS_CKVN))
#define QM ((bf16*)(ws + WS_QM))
#define KV ((bf16*)(ws + WS_KV))
#define O ((bf16*)(ws + WS_O))
#define OP ((bf16*)(ws + WS_OP))
#define ACT ((bf16*)(ws + WS_ACT))
#define Y ((bf16*)(ws + WS_Y))

    REP(0)
    {
        PH_IDS
        const float* c = (const float*)a.in[I_C]; const float* w = (const float*)a.in[I_WADA]; const float* bias = (const float*)a.in[I_BADA];
        LAS float* cact = (LAS float*)lds; LAS float* red = (LAS float*)(lds + 32768);
        __syncthreads();
        { float cv[16];
#pragma unroll
          for (int i = 0; i < 16; ++i) cv[i] = c[tid + 512 * i];
#pragma unroll
          for (int i = 0; i < 16; ++i) cact[tid + 512 * i] = cv[i] / (1.f + expf(-cv[i])); }
        __syncthreads();
        for (int cb = blockIdx.x; cb < 192; cb += G) {
            const int cc = tid & 31, ks = tid >> 5, col = cb * 32 + cc;
            const float bsv = tid < 256 ? bias[cb * 32 + (tid & 31)] : 0.f;
            float acc[8];
#pragma unroll
            for (int b = 0; b < 8; ++b) acc[b] = 0.f;
#pragma unroll
            for (int i = 0; i < 64; ++i) { const int k = ks * 64 + i; const float wv = __builtin_nontemporal_load(w + (size_t)k * 6144 + col);
#pragma unroll
                for (int b = 0; b < 8; ++b) acc[b] += cact[b * 1024 + k] * wv; }
#pragma unroll
            for (int b = 0; b < 8; ++b) red[(ks * 8 + b) * 32 + cc] = acc[b];
            __syncthreads();
            if (tid < 256) { const int b = tid >> 5, c2 = tid & 31; float s = bsv;
                for (int k2 = 0; k2 < 16; ++k2) s += red[(k2 * 8 + b) * 32 + c2];
                ADA[b * 6144 + cb * 32 + c2] = s; }
            __syncthreads();
        }
    }
    xcd_barrier(bar);

    REP(1)
    {
        PH_IDS
        const float* g = (const float*)a.in[I_GAPRE];
        constexpr int I_IN = 16 * 64, I_UQ = 4 * 24, I_UKV = 2 * 32, I_OUT = 16 * 32;
        constexpr int NIT = I_IN + I_UQ + I_UKV + I_OUT;
        LAS float* scr = (LAS float*)(lds + wave * 17408);
        float tv[32]; TItem ti; ti.valid = false; ti.WT = nullptr; ti.K = 0; ti.k0 = 0; ti.n0 = 0; ti.wsc = 0.f;
        const int* pos = (const int*)a.in[I_POS]; const int ib0 = blockIdx.x * 512 + tid; int pv0[4];
#pragma unroll
        for (int q = 0; q < 4; ++q) { const int i = ib0 + q * G * 512; pv0[q] = i < T * 16 ? pos[i >> 4] : 0; }
        if (gw < NIT) {
            int r = gw;
            if (r < I_IN) titem_load((const float*)a.in[I_WIN], 1024, INW, (bf16*)(ws + WS_WIN), r, 64, lane, [](int n) { return inproj_src(n); }, tv, ti);
            else if ((r -= I_IN) < I_UQ) titem_load((const float*)a.in[I_WUQ], 256, QW, (bf16*)(ws + WS_WUQ), r, 24, lane, [](int n) { return n; }, tv, ti);
            else if ((r -= I_UQ) < I_UKV) titem_load((const float*)a.in[I_WUKV], 128, KVW, (bf16*)(ws + WS_WUKV), r, 32, lane, [](int n) { return n; }, tv, ti);
            else { r -= I_UKV; titem_load((const float*)a.in[I_WOUT], 1024, D, (bf16*)(ws + WS_WOUT), r, 32, lane, [](int n) { return n; }, tv, ti); }
        }
        for (int ch = gw; ch < T / 16; ch += NGW) {
            const int t0 = ch * 16, b = t0 / SEQ; const float* sh = ADA + b * 6144; const float* sc = sh + 1024;
            f32x4 gs[4], hs[4];
#pragma unroll
            for (int j = 0; j < 4; ++j) { gs[j] = ((const f32x4*)g)[lane + 64 * j] * (((const f32x4*)sc)[lane + 64 * j] + 1.f); hs[j] = ((const f32x4*)sh)[lane + 64 * j]; }
            for (int i = 0; i < 16; i += 4) {
                f32x4 v[4][4];
#pragma unroll
                for (int r = 0; r < 4; ++r)
#pragma unroll
                    for (int j = 0; j < 4; ++j) v[r][j] = __builtin_nontemporal_load((const f32x4*)(XIN + (size_t)(t0 + i + r) * D) + lane + 64 * j);
#pragma unroll
                for (int r = 0; r < 4; ++r) { float s = 0.f;
#pragma unroll
                    for (int j = 0; j < 4; ++j) s += v[r][j].x * v[r][j].x + v[r][j].y * v[r][j].y + v[r][j].z * v[r][j].z + v[r][j].w * v[r][j].w;
                    const float rstd = 1.f / sqrtf(wave_sum(s) * (1.f / D) + RMS_EPS);
                    u32x2* o8 = (u32x2*)(H + (size_t)(t0 + i + r) * D) + lane;
#pragma unroll
                    for (int j = 0; j < 4; ++j) { const f32x4 q = v[r][j] * rstd * gs[j] + hs[j]; u32x2 o; o.x = pk2(q.x, q.y); o.y = pk2(q.z, q.w); o8[64 * j] = o; } }
            }
        }
        if (ti.valid) titem_finish(tv, ti, scr, lane);
        for (int it = gw + NGW; it < NIT; it += NGW) {
            int r = it;
            if (r < I_IN) { transpose_item((const float*)a.in[I_WIN], 1024, INW, (bf16*)(ws + WS_WIN), scr, r, 64, lane, [](int n) { return inproj_src(n); }); continue; } r -= I_IN;
            if (r < I_UQ) { transpose_item((const float*)a.in[I_WUQ], 256, QW, (bf16*)(ws + WS_WUQ), scr, r, 24, lane, [](int n) { return n; }); continue; } r -= I_UQ;
            if (r < I_UKV) { transpose_item((const float*)a.in[I_WUKV], 128, KVW, (bf16*)(ws + WS_WUKV), scr, r, 32, lane, [](int n) { return n; }); continue; } r -= I_UKV;
            transpose_item((const float*)a.in[I_WOUT], 1024, D, (bf16*)(ws + WS_WOUT), scr, r, 32, lane, [](int n) { return n; });
        }
        for (int ib = blockIdx.x * 512 + tid; ib < T * 16; ib += 4 * G * 512) {
            int pv[4];
#pragma unroll
            for (int q = 0; q < 4; ++q) { const int i = ib + q * G * 512; pv[q] = ib == ib0 ? pv0[q] : (i < T * 16 ? pos[i >> 4] : 0); }
#pragma unroll
            for (int q = 0; q < 4; ++q) { const int i = ib + q * G * 512;
                if (i < T * 16) { const int j = i & 15;
                    float inv = 1.f;
                    { constexpr float INVF[16] = {1.0f, 0.5623413324356079f, 0.3162277638912201f, 0.17782793939113617f, 0.10000000149011612f, 0.05623413249850273f, 0.03162277489900589f, 0.017782794311642647f, 0.009999999776482582f, 0.005623413249850273f, 0.003162277629598975f, 0.0017782794311642647f, 0.0010000000474974513f, 0.000562341301701963f, 0.0003162277571391314f, 0.00017782794020604342f};
#pragma unroll
                      for (int z = 0; z < 16; ++z) inv = j == z ? INVF[z] : inv; }
                    const float ang = (float)pv[q] * inv;
                    const double ad = (double)ang; const double n = rint(ad * 0.15915494309189535); const float r = (float)(ad - n * 6.283185307179586);
                    COS[i] = cosf(r); SIN[i] = sinf(r); } }
        }
    }
    xcd_barrier(bar);

    REP(2)
    {
        g8::DenseSched S; S.init(H, ws + WS_WIN, T, PW, D, G, (int)blockIdx.x); S.spread = true;
        g8::EpiProj E{PROJ, ctl + CW_NRM, CQN, CKVN, KR, LF, (float*)(ws + WS_CS), COS, SIN, (const float*)a.in[I_GQ], (const float*)a.in[I_GKV], (const float*)a.in[I_BF], (LAS float*)(lds + 131072)};
        g8::gemm_phase<g8::EpiProj, g8::DenseSched, true>(lds, D, S, E);
    }
    xcd_barrier(bar);

    { PH_IDS
      LAS float* pre = (LAS float*)lds; const float* CS = (const float*)(ws + WS_CS);
      for (int sq = (G >= 192 ? (int)blockIdx.x - 128 : (int)blockIdx.x); sq < 64; sq += G) {
        if (sq < 0) break;
        const int b = sq >> 3, h = sq & 7;
        float lf[SEQ / 512];
#pragma unroll
        for (int k = 0; k < SEQ / 512; ++k) lf[k] = LF[((size_t)b * SEQ + tid + 512 * k) * 8 + h];
        if (wave == 0) {
            float c[4], s = 0.f;
#pragma unroll
            for (int j = 0; j < 4; ++j) { c[j] = CS[(size_t)(b * 256 + 4 * lane + j) * 8 + h]; s += c[j]; }
            float incl = s;
#pragma unroll
            for (int o = 1; o < 64; o <<= 1) { const float u = __shfl_up(incl, o); if (lane >= o) incl += u; }
            float e0 = incl - s;
#pragma unroll
            for (int j = 0; j < 4; ++j) { pre[4 * lane + j] = e0; e0 += c[j]; }
        }
        __syncthreads();
#pragma unroll
        for (int k = 0; k < SEQ / 512; ++k) { const int i = tid + 512 * k; const size_t idx = ((size_t)b * SEQ + i) * 8 + h; const float f2 = (lf[k] + pre[i >> 4]) * LOG2E; FT[idx] = f2;
            const float nf = -f2; const unsigned hi = f2bf(nf); const float r1 = nf - __uint_as_float(hi << 16); const unsigned mid = f2bf(r1); const float r2 = r1 - __uint_as_float(mid << 16); const unsigned lo = f2bf(r2);
            u32x4 o; o.x = hi | (mid << 16); o.y = lo; o.z = 0u; o.w = 0u; *(u32x4*)(KB + idx * 8) = o; }
        __syncthreads();
      }
    }

    __syncthreads();
    REP(4) {
    {
        g8::DenseSched S; S.init(CQN, ws + WS_WUQ, T, QW, 256, G, (int)blockIdx.x);
        g8::EpiQ E{QM, COS, SIN};
        g8::gemm_phase<g8::EpiQ, g8::DenseSched, true>(lds, 256, S, E);
    }
    {
        g8::DenseSched S; S.init(CKVN, ws + WS_WUKV, T, KVW, 128, G, (int)blockIdx.x);
        g8::EpiBf16Out E{KV, KVW, 0, 0, 1.f};
        g8::gemm_phase<g8::EpiBf16Out, g8::DenseSched, true>(lds, 128, S, E);
    }
    }
    xcd_barrier(bar);

    REP(5)
    {
        PH_IDS
        const int xg = blockIdx.x & 7, jg = blockIdx.x >> 3, nj = G >> 3, ncvj = nj > 8 ? 4 : 1;
        if (jg >= nj - ncvj || G < 8) {
            const int ncw = (G < 8 ? G : ncvj * 8) * 8, cw = (G < 8 ? (int)blockIdx.x : (jg - (nj - ncvj)) * 8 + xg) * 8 + wave;
            LAS unsigned char* tile = (LAS unsigned char*)(lds + wave * 17408);
            for (int it = cw; it < NE * 192; it += ncw) {
                const int e = it / 192; int r = it - e * 192;
                if (r < 128) { const int nb = r & 15, kb = r >> 4, n0 = 128 * nb, srcc = ((n0 >> 7) & 1) * 1024 + (n0 >> 8) * 128;
                    f8x_item((const float*)a.in[I_WGU] + (size_t)e * 1024 * 2048 + (size_t)(128 * kb) * 2048 + srcc, 2048, ws + WS_WGU + (size_t)e * 2048 * 1024 + (size_t)n0 * 1024 + 128 * kb, tile, lane, W8_SCALE); }
                else { r -= 128; const int nb = r & 7, kb = r >> 3, n0 = 128 * nb;
                    f8x_item((const float*)a.in[I_WDN] + (size_t)e * 1024 * 1024 + (size_t)(128 * kb) * 1024 + n0, 1024, ws + WS_WDN + (size_t)e * 1024 * 1024 + (size_t)n0 * 1024 + 128 * kb, tile, lane, W8_SCALE); }
            }
            __syncthreads();
        }
        {
          const unsigned* NRM = ctl + CW_NRM; const float* FTp = (const float*)(ws + WS_FT);
          for (int xq = xg;;) {
            float BqL = 0.f;
            if (lane < 8) {
                const float qn = __uint_as_float(__hip_atomic_load(NRM + ((0 * NB + xq) * 8 + lane) * 2, __ATOMIC_RELAXED, __HIP_MEMORY_SCOPE_AGENT)) + __uint_as_float(__hip_atomic_load(NRM + ((0 * NB + xq) * 8 + lane) * 2 + 1, __ATOMIC_RELAXED, __HIP_MEMORY_SCOPE_AGENT));
                const float kn = __uint_as_float(__hip_atomic_load(NRM + ((1 * NB + xq) * 8 + lane) * 2, __ATOMIC_RELAXED, __HIP_MEMORY_SCOPE_AGENT)) + __uint_as_float(__hip_atomic_load(NRM + ((1 * NB + xq) * 8 + lane) * 2 + 1, __ATOMIC_RELAXED, __HIP_MEMORY_SCOPE_AGENT));
                BqL = sqrtf(qn * kn) * 1.02f + 4.f; }
            unsigned popped = 0;
            if (tid == 0) popped = __hip_atomic_fetch_add(ctl + CW_Q + 64 * xq, 1u, __ATOMIC_RELAXED, __HIP_MEMORY_SCOPE_AGENT);
            for (;;) {
                if (tid == 0) MISC[4] = popped;
                __syncthreads();
                const int idx = __builtin_amdgcn_readfirstlane((int)MISC[4]);
                __syncthreads();
                if (idx >= 256) break;
                if (tid == 0) popped = __hip_atomic_fetch_add(ctl + CW_Q + 64 * xq, 1u, __ATOMIC_RELAXED, __HIP_MEMORY_SCOPE_AGENT);
                const int qb = 15 - ((idx & 127) >> 3), h = idx & 7;
                if (idx < 128) { attn::attn_unit<true, 8>(xq, h, qb, ws, (char*)lds_raw); continue; }
                const int NTf = 4 * qb + 4; const long rowbase = (long)xq * SEQ;
                const float Bq = __builtin_amdgcn_readlane(BqL, h);
                const float Gp = qb > 0 ? attn::fox_prepass(xq, h, qb, ws, (char*)lds_raw) : 0.f;
                bool dead = false;
                if (lane < NTf - 4) { const float fj = FTp[(rowbase + 64 * lane + 63) * 8 + h]; dead = (Bq - fj + Gp) < -40.f; }
                const unsigned long long bm = __ballot(dead);
                int n0 = bm == ~0ull ? 64 : __builtin_ctzll(~bm); n0 = __builtin_amdgcn_readfirstlane(n0 & ~1);
                attn::attn_unit<false, 8>(xq, h, qb, ws, (char*)lds_raw, n0);
            }
            if (wave == 0) { unsigned cq = 256u; if (lane < 8) cq = __hip_atomic_load(ctl + CW_Q + 64 * lane, __ATOMIC_RELAXED, __HIP_MEMORY_SCOPE_AGENT);
                const unsigned long long mq = __ballot(cq < 256u); if (lane == 0) MISC[5] = (unsigned)mq; }
            __syncthreads();
            const unsigned mleft = (unsigned)__builtin_amdgcn_readfirstlane((int)MISC[5]) & 0xffu;
            __syncthreads();
            if (mleft == 0u) break;
            { const unsigned rot = ((mleft >> xg) | (mleft << (8 - xg))) & 0xffu; xq = (xg + __builtin_ctz(rot)) & 7; }
          }
        }
    }
    xcd_barrier(bar);

    REP(6)
    {
        g8::DenseSched S; S.init(O, ws + WS_WOUT, T, D, D, G, (int)blockIdx.x);
        g8::EpiBf16Out E{OP, D, 0, 0, 1.f};
        g8::gemm_phase<g8::EpiBf16Out, g8::DenseSched, true>(lds, D, S, E);
    }
    xcd_barrier(bar);

    {
        PH_IDS
        const float* gpost = (const float*)a.in[I_GAPOST]; const float* gpre = (const float*)a.in[I_GMPRE];
        const float* wr = (const float*)a.in[I_WR]; const float* br = (const float*)a.in[I_BR];
        LAS float* hT = (LAS float*)lds;
        LAS float* part = (LAS float*)(lds + 65536);
        LAS int* lcnt = (LAS int*)(lds + 131072); LAS int* lbase = lcnt + 32; LAS int* lpos = lcnt + 64; LAS int* le = lpos + 512; LAS int* lgt = le + 512;
        const int tt = lane & 15, g4 = lane >> 4;
        g8::bf16x8 Whi[4][2], Wlo[4][2];
#pragma unroll
        for (int ks = 0; ks < 4; ++ks)
#pragma unroll
            for (int eb = 0; eb < 2; ++eb)
#pragma unroll
                for (int j = 0; j < 8; ++j) { const float f = wr[(size_t)(wave * 128 + ks * 32 + 8 * g4 + j) * 32 + eb * 16 + tt]; const unsigned h = f2bf(f); const unsigned l = f2bf(f - __uint_as_float(h << 16));
                    Whi[ks][eb][j] = (short)h; Wlo[ks][eb][j] = (short)l; }
        const int myE = lane & 31, myR = lane >> 5; const float brE = br[myE];
        for (int ch = blockIdx.x; ch < T / 128; ch += G) {
            const int b = (ch * 128) / SEQ; const float* ada = ADA + b * 6144;
            LAS f32x4* cst = (LAS f32x4*)(lds + 98304);
            if (tid < 32) lcnt[tid] = 0;
            { int tq = threadIdx.x; asm volatile("" : "+v"(tq));
              if (tq < 256) { cst[tq] = ((const f32x4*)gpost)[tq] * ((const f32x4*)(ada + 2048))[tq]; cst[256 + tq] = ((const f32x4*)gpre)[tq] * (((const f32x4*)(ada + 4096))[tq] + 1.f); cst[512 + tq] = ((const f32x4*)(ada + 3072))[tq]; } }
            __syncthreads();
            f32x4 v[2][4], vn[2][4]; u32x2 p[2][4], pn[2][4];
#define P7_LOAD(P_, V_, tok) do { _Pragma("unroll") for (int r = 0; r < 2; ++r) _Pragma("unroll") for (int j = 0; j < 4; ++j) { \
                P_[r][j] = __builtin_nontemporal_load((const u32x2*)(OP + (size_t)((tok) + r) * D) + lane + 64 * j); V_[r][j] = __builtin_nontemporal_load((const f32x4*)(XIN + (size_t)((tok) + r) * D) + lane + 64 * j); } } while (0)
            P7_LOAD(pn, vn, ch * 128 + wave * 2);
#pragma unroll 1
            for (int it = 0; it < 10; ++it) {
                const bool doA = it < 8, doB = it >= 1 && it <= 8, doC = it >= 2;
                if (doA) {
                    const int t0 = ch * 128 + it * 16 + wave * 2;
#pragma unroll
                    for (int r = 0; r < 2; ++r)
#pragma unroll
                        for (int j = 0; j < 4; ++j) { p[r][j] = pn[r][j]; v[r][j] = vn[r][j]; }
                    float rs[2];
#pragma unroll
                    for (int r = 0; r < 2; ++r) { float s = 0.f;
#pragma unroll
                        for (int j = 0; j < 4; ++j) { const float a0 = bflo(p[r][j].x), a1 = bfhi(p[r][j].x), a2 = bflo(p[r][j].y), a3 = bfhi(p[r][j].y); s += a0 * a0 + a1 * a1 + a2 * a2 + a3 * a3; }
                        rs[r] = 1.f / sqrtf(wave_sum(s) * (1.f / D) + RMS_EPS); }
                    float s2[2] = {0.f, 0.f};
#pragma unroll
                    for (int j = 0; j < 4; ++j) { const f32x4 cA = cst[lane + 64 * j];
#pragma unroll
                        for (int r = 0; r < 2; ++r) { const f32x4 o4 = (f32x4){bflo(p[r][j].x), bfhi(p[r][j].x), bflo(p[r][j].y), bfhi(p[r][j].y)};
                            v[r][j] = v[r][j] + cA * (o4 * rs[r]); { u32x2 xb; xb.x = pk2(v[r][j].x, v[r][j].y); xb.y = pk2(v[r][j].z, v[r][j].w); ((u32x2*)((bf16*)(ws + WS_X1) + (size_t)(t0 + r) * D))[lane + 64 * j] = xb; }
                            s2[r] += v[r][j].x * v[r][j].x + v[r][j].y * v[r][j].y + v[r][j].z * v[r][j].z + v[r][j].w * v[r][j].w; } }
#pragma unroll
                    for (int r = 0; r < 2; ++r) rs[r] = 1.f / sqrtf(wave_sum(s2[r]) * (1.f / D) + RMS_EPS);
#pragma unroll
                    for (int j = 0; j < 4; ++j) { const f32x4 cB = cst[256 + lane + 64 * j], cH = cst[512 + lane + 64 * j];
#pragma unroll
                        for (int r = 0; r < 2; ++r) { v[r][j] = v[r][j] * rs[r] * cB + cH;
                            ((unsigned*)((unsigned char*)H + (size_t)(t0 + r) * D))[lane + 64 * j] = g8::pk4_fp8(v[r][j].x, v[r][j].y, v[r][j].z, v[r][j].w); } }
                    __builtin_amdgcn_sched_barrier(0);
                    if (it < 7) { P7_LOAD(pn, vn, t0 + 16); }
                    __builtin_amdgcn_sched_barrier(0);
                }
                if (doB) {
                    LAS float* partW = part + ((it - 1) & 1) * 4096;
                    f32x4 dacc[2] = {{0.f, 0.f, 0.f, 0.f}, {0.f, 0.f, 0.f, 0.f}};
#pragma unroll
                    for (int ks = 0; ks < 4; ++ks) { const int c0 = (wave * 128 + ks * 32 + 8 * g4) >> 2;
                        const f32x4 fa = *(const LAS f32x4*)(hT + tt * 1024 + 4 * (c0 ^ tt)), fb = *(const LAS f32x4*)(hT + tt * 1024 + 4 * ((c0 + 1) ^ tt));
                        g8::bf16x8 Bhi, Blo;
#pragma unroll
                        for (int j = 0; j < 8; ++j) { const float f = j < 4 ? fa[j & 3] : fb[j & 3]; const unsigned h = f2bf(f); const unsigned l = f2bf(f - __uint_as_float(h << 16)); Bhi[j] = (short)h; Blo[j] = (short)l; }
#pragma unroll
                        for (int eb = 0; eb < 2; ++eb) { dacc[eb] = __builtin_amdgcn_mfma_f32_16x16x32_bf16(Whi[ks][eb], Bhi, dacc[eb], 0, 0, 0);
                            dacc[eb] = __builtin_amdgcn_mfma_f32_16x16x32_bf16(Whi[ks][eb], Blo, dacc[eb], 0, 0, 0); dacc[eb] = __builtin_amdgcn_mfma_f32_16x16x32_bf16(Wlo[ks][eb], Bhi, dacc[eb], 0, 0, 0); } }
#pragma unroll
                    for (int eb = 0; eb < 2; ++eb) *(LAS f32x4*)(partW + (wave * 16 + tt) * 32 + 16 * eb + 4 * g4) = dacc[eb];
                }
                if (doC) {
                    const int lt0 = (it - 2) * 16 + wave * 2, t0 = ch * 128 + lt0; const LAS float* partR = part + (it & 1) * 4096;
                    float lg = brE;
#pragma unroll
                    for (int wv = 0; wv < 8; ++wv) lg += partR[(wv * 16 + 2 * wave + myR) * 32 + myE];
                    int te[2][4]; float tg[2][4];
                    { float tv[2][4]; float cur = lg;
#define P7_DPPF(x, ctrl) __int_as_float(__builtin_amdgcn_update_dpp(0, __float_as_int(x), (ctrl), 0xF, 0xF, true))
#pragma unroll
                      for (int i = 0; i < 4; ++i) { float m = cur;
                          m = fmaxf(m, P7_DPPF(m, 0xB1)); m = fmaxf(m, P7_DPPF(m, 0x4E)); m = fmaxf(m, P7_DPPF(m, 0x141)); m = fmaxf(m, P7_DPPF(m, 0x140));
                          m = fmaxf(m, __int_as_float(__builtin_amdgcn_ds_swizzle(__float_as_int(m), 0x401F)));
                          const unsigned long long mk = __ballot(cur == m); const int l0 = __builtin_ctz((unsigned)mk), l1 = __builtin_ctz((unsigned)(mk >> 32));
                          te[0][i] = l0; te[1][i] = l1; tv[0][i] = __uint_as_float(__builtin_amdgcn_readlane(__float_as_uint(m), 0)); tv[1][i] = __uint_as_float(__builtin_amdgcn_readlane(__float_as_uint(m), 32));
                          if (lane == l0 || lane == 32 + l1) cur = -INFINITY; }
#undef P7_DPPF
#pragma unroll
                      for (int r = 0; r < 2; ++r) { const float e1 = expf(tv[r][1] - tv[r][0]), e2 = expf(tv[r][2] - tv[r][0]), e3 = expf(tv[r][3] - tv[r][0]); const float inv = 1.f / (1.f + e1 + e2 + e3);
                          tg[r][0] = inv; tg[r][1] = e1 * inv; tg[r][2] = e2 * inv; tg[r][3] = e3 * inv; } }
                    if (lane < 8) { const int r = lane >> 2, i = lane & 3;
                        const int me = r == 0 ? (i == 0 ? te[0][0] : i == 1 ? te[0][1] : i == 2 ? te[0][2] : te[0][3]) : (i == 0 ? te[1][0] : i == 1 ? te[1][1] : i == 2 ? te[1][2] : te[1][3]);
                        const float mg = r == 0 ? (i == 0 ? tg[0][0] : i == 1 ? tg[0][1] : i == 2 ? tg[0][2] : tg[0][3]) : (i == 0 ? tg[1][0] : i == 1 ? tg[1][1] : i == 2 ? tg[1][2] : tg[1][3]);
                        TOPG[(t0 + r) * 4 + i] = mg;
                        const int pp = __hip_atomic_fetch_add(lcnt + me, 1, __ATOMIC_RELAXED, __HIP_MEMORY_SCOPE_WORKGROUP);
                        lpos[(lt0 + r) * 4 + i] = pp; le[(lt0 + r) * 4 + i] = me; lgt[(lt0 + r) * 4 + i] = (int)__float_as_uint(mg); }
                }
                __syncthreads();
                if (doA) {
#pragma unroll
                    for (int j = 0; j < 4; ++j)
#pragma unroll
                        for (int r = 0; r < 2; ++r) *(LAS f32x4*)(hT + (2 * wave + r) * 1024 + 4 * ((lane + 64 * j) ^ ((2 * wave + r) & 15))) = v[r][j];
                }
                __syncthreads();
            }
#undef P7_LOAD
            __syncthreads();
            { int t3 = threadIdx.x; asm volatile("" : "+v"(t3));
              if (t3 < 32) lbase[t3] = (int)__hip_atomic_fetch_add(ctl + CW_CNT + 64 * t3, (unsigned)lcnt[t3], __ATOMIC_RELAXED, __HIP_MEMORY_SCOPE_AGENT);
              __syncthreads();
              { const int e = le[t3]; const int pos = lbase[e] + lpos[t3]; u32x2 rec; rec.x = (unsigned)(ch * 512 + t3); rec.y = (unsigned)lgt[t3]; ((u32x2*)LIST)[(size_t)e * T + pos] = rec;
                TOPE[ch * 512 + t3] = (e << 16) | pos; } }
            __syncthreads();
        }
    }
    xcd_barrier(bar);

#define MOE_TABLES PH_IDS int cntE = 0; if (lane < 32) cntE = (int)__hip_atomic_load(ctl + CW_CNT + 64 * lane, __ATOMIC_RELAXED, __HIP_MEMORY_SCOPE_AGENT); \
        int pend256, ebaseE, tot256; { const int n2 = (cntE + 255) >> 8; int i1 = n2; \
          _Pragma("unroll") for (int o = 1; o < 32; o <<= 1) { const int u1 = __shfl_up(i1, o); if (lane >= o) i1 += u1; } \
          pend256 = i1; ebaseE = (i1 - n2) * 256; tot256 = __shfl(i1, 31); }
    REP(8)
    {
        MOE_TABLES
        g8::MoeSched<true> S{cntE, pend256, ebaseE, tot256, 8, G, (int)blockIdx.x, D / 2, lane, (const char*)H, (const char*)(ws + WS_WGU), (size_t)2048 * 1024, LIST};
        g8::EpiGU8 E{(unsigned char*)ACT, (const float*)a.in[I_BGU], 1.f / W8_SCALE, (const LAS float*)(lds + 131072)};
        if (G == 256) { const int xs = (int)blockIdx.x & 7, js = (int)blockIdx.x >> 3; dephase(xs < 4 ? (xs * 32 + js) : 128 + ((xs - 4) * 32 + js) * 5 / 2); }
        g8::gemm_phase<g8::EpiGU8, g8::MoeSched<true>, true, true>(lds, D / 2, S, E);
    }
    xcd_barrier(bar);

    REP(9)
    {
        MOE_TABLES
        g8::MoeSched<false> S{cntE, pend256, ebaseE, tot256, 4, G, (int)blockIdx.x, D / 2, lane, (const char*)ACT, (const char*)(ws + WS_WDN), (size_t)1024 * 1024, LIST};
        g8::EpiDown E{(unsigned char*)Y, (const float*)a.in[I_BDN], 1.f / W8_SCALE, (const LAS float*)(lds + 131072)};
        if (G == 256) { const int xs = (int)blockIdx.x & 7, js = (int)blockIdx.x >> 3; dephase(xs < 2 ? (xs * 32 + js) : 64 + ((xs - 2) * 32 + js) * 2); }
        g8::gemm_phase<g8::EpiDown, g8::MoeSched<false>, true, true>(lds, D / 2, S, E);
    }
    xcd_barrier(bar);
#undef MOE_TABLES

    for (int rep10_ = 0; rep10_ < ((PROBE_PHASE) == 10 ? 2 : 1); ++rep10_)
    {
        PH_IDS
        int ebaseE;
        { int cntE = 0; if (lane < 32) cntE = (int)__hip_atomic_load(ctl + CW_CNT + 64 * lane, __ATOMIC_RELAXED, __HIP_MEMORY_SCOPE_AGENT);
          const int n2 = (cntE + 255) >> 8; int i1 = n2;
#pragma unroll
          for (int o = 1; o < 32; o <<= 1) { const int u1 = __shfl_up(i1, o); if (lane >= o) i1 += u1; }
          ebaseE = (i1 - n2) * 256; }
        const float* gpost = (const float*)a.in[I_GMPOST];
        for (int ch = gw; ch < T / 16; ch += NGW) {
            const int t0 = ch * 16, b = t0 / SEQ; const float* gtm = ADA + b * 6144 + 5120;
            f32x4 gg[4];
#pragma unroll
            for (int j = 0; j < 4; ++j) gg[j] = ((const f32x4*)gpost)[lane + 64 * j] * ((const f32x4*)gtm)[lane + 64 * j];
            unsigned y[2][4][4], yn[2][4][4]; u32x2 xo[2][4], xn[2][4]; float gq[2][4], gqn[2][4];
#define P10_LOAD(Y_, X_, G_, tok) do { _Pragma("unroll") for (int r = 0; r < 2; ++r) { _Pragma("unroll") for (int q = 0; q < 4; ++q) { \
                const int ip_ = __builtin_amdgcn_readfirstlane(TOPE[((tok) + r) * 4 + q]); const int row_ = __builtin_amdgcn_readlane(ebaseE, ip_ >> 16) + (ip_ & 0xffff); G_[r][q] = TOPG[((tok) + r) * 4 + q]; \
                _Pragma("unroll") for (int j = 0; j < 4; ++j) Y_[r][q][j] = __builtin_nontemporal_load((const unsigned*)((const unsigned char*)Y + (size_t)row_ * D) + lane + 64 * j); } \
                _Pragma("unroll") for (int j = 0; j < 4; ++j) X_[r][j] = __builtin_nontemporal_load((const u32x2*)((const bf16*)(ws + WS_X1) + (size_t)((tok) + r) * D) + lane + 64 * j); } } while (0)
            P10_LOAD(yn, xn, gqn, t0);
            for (int i = 0; i < 16; i += 2) {
#pragma unroll
                for (int r = 0; r < 2; ++r) {
#pragma unroll
                    for (int q = 0; q < 4; ++q)
#pragma unroll
                        for (int j = 0; j < 4; ++j) y[r][q][j] = yn[r][q][j];
#pragma unroll
                    for (int j = 0; j < 4; ++j) xo[r][j] = xn[r][j];
#pragma unroll
                    for (int q = 0; q < 4; ++q) gq[r][q] = gqn[r][q]; }
                if (i < 14) { P10_LOAD(yn, xn, gqn, t0 + i + 2); }
                __builtin_amdgcn_sched_barrier(0);
#pragma unroll
                for (int r = 0; r < 2; ++r) { f32x4 v[4]; float s = 0.f;
#pragma unroll
                    for (int j = 0; j < 4; ++j) { f32x4 acc = {0.f, 0.f, 0.f, 0.f};
#pragma unroll
                        for (int q = 0; q < 4; ++q) { const int w = (int)y[r][q][j]; acc += (f32x4){__builtin_amdgcn_cvt_f32_fp8(w, 0), __builtin_amdgcn_cvt_f32_fp8(w, 1), __builtin_amdgcn_cvt_f32_fp8(w, 2), __builtin_amdgcn_cvt_f32_fp8(w, 3)} * gq[r][q]; }
                        acc = acc * (1.f / Y8_SCALE); v[j] = acc; s += acc.x * acc.x + acc.y * acc.y + acc.z * acc.z + acc.w * acc.w; }
                    const float rstd = 1.f / sqrtf(wave_sum(s) * (1.f / D) + RMS_EPS);
#pragma unroll
                    for (int j = 0; j < 4; ++j) __builtin_nontemporal_store((f32x4){bflo(xo[r][j].x), bfhi(xo[r][j].x), bflo(xo[r][j].y), bfhi(xo[r][j].y)} + gg[j] * (v[j] * rstd), (f32x4*)(((PROBE_PHASE) == 10 && rep10_ == 0 ? (float*)(ws + WS_H) : a.out) + (size_t)(t0 + i + r) * D) + lane + 64 * j); }
            }
#undef P10_LOAD
        }
    }
}

#undef XIN
#undef ADA
#undef COS
#undef SIN
#undef LF
#undef FT
#undef KB
#undef KR
#undef TOPE
#undef TOPG
#undef LIST
#undef H
#undef PROJ
#undef CQN
#undef CKVN
#undef QM
#undef KV
#undef O
#undef OP
#undef ACT
#undef Y
extern "C" void kernel_launch(void* const* d_in, const int* in_sizes, int n_in, void* d_out, int out_size, void* d_ws, size_t ws_size, hipStream_t stream) {
    static int grid = 0;
    if (grid == 0) {
        if (n_in != 22 || out_size != T * D || ws_size < WS_END) { fprintf(stderr, "kernel_launch: unexpected shapes (n_in %d out %d ws %zu)\n", n_in, out_size, ws_size); grid = -1; return; }
        int dev = 0, cus = 0, per_cu = 0;
        if (hipGetDevice(&dev) != hipSuccess || hipDeviceGetAttribute(&cus, hipDeviceAttributeMultiprocessorCount, dev) != hipSuccess) { grid = -1; return; }
        if (hipFuncSetAttribute((const void*)fwd, hipFuncAttributeMaxDynamicSharedMemorySize, LDS_BYTES) != hipSuccess) { fprintf(stderr, "kernel_launch: hipFuncSetAttribute failed\n"); grid = -1; return; }
        if (hipOccupancyMaxActiveBlocksPerMultiprocessor(&per_cu, (const void*)fwd, 512, LDS_BYTES) != hipSuccess || per_cu < 1) fprintf(stderr, "kernel_launch: occupancy query says %d\n", per_cu);
        (void)hipGetLastError();
        grid = cus;
    }
    if (grid < 0) return;
    (void)hipMemsetAsync((char*)d_ws + WS_CTL, 0, CTL_ZERO_BYTES, stream);
    Args a{};
    for (int i = 0; i < 22; ++i) a.in[i] = d_in[i];
    a.out = (float*)d_out; a.ws = (unsigned char*)d_ws;
    hipLaunchKernelGGL(fwd, dim3(grid), dim3(512), LDS_BYTES, stream, a);
}
```
